# Optimizing an MI355X kernel written in HIP

```python
import jax, jax.numpy as jnp
from jax import lax
import numpy as np

D_MODEL = 2048
BATCH = 4
SEQ = 4096
DEPTH = 1

HEAD_DIM = D_MODEL // 16
FOX_HEADS = 6
SWA_HEADS = 6
SWA_KV_HEADS = 2
MEM_HEADS = 4
MEM_LEN = 256
WINDOW = 128
Q_BLOCK = 128
D_FF = 5632
EPS = 1e-6
NEG_INF = -1e30

FOX_W = FOX_HEADS * HEAD_DIM
SWA_Q_W = SWA_HEADS * HEAD_DIM
SWA_KV_W = SWA_KV_HEADS * HEAD_DIM
MEM_W = MEM_HEADS * HEAD_DIM
MIX_WIDTH = FOX_W + SWA_Q_W + MEM_W
IN_SPLITS = [FOX_W, FOX_W, FOX_W, FOX_HEADS, SWA_Q_W, SWA_KV_W, SWA_KV_W, MEM_W]
IN_WIDTH = int(sum(IN_SPLITS))
IN_CUTS = [int(c) for c in np.cumsum(IN_SPLITS)[:-1]]

kernel_name = "hybrid_fox_swa_memory_macaron"


def rms_norm(x, g):
    xf = x.astype(jnp.float32)
    y = xf * lax.rsqrt(jnp.mean(xf * xf, axis=-1, keepdims=True) + EPS)
    return (y * g.astype(jnp.float32)).astype(x.dtype)


def swiglu(x, w_gate, w_up, w_down):
    return (jax.nn.silu(x @ w_gate) * (x @ w_up)) @ w_down


def alibi_slopes(n):
    return jnp.asarray(2.0 ** (-8.0 * np.arange(1, n + 1) / n), dtype=jnp.float32)


def forgetting_attention(q, k, v, log_f):
    B, S, H, D = q.shape
    nb = S // Q_BLOCK
    scale = D ** -0.5
    c = jnp.cumsum(log_f, axis=1)
    c_k = c.transpose(0, 2, 1)
    kf = k.astype(jnp.float32)
    vf = v.astype(jnp.float32)
    qb = q.astype(jnp.float32).reshape(B, nb, Q_BLOCK, H, D).transpose(1, 0, 2, 3, 4)
    cb = c.reshape(B, nb, Q_BLOCK, H).transpose(1, 0, 3, 2)
    kpos = jnp.arange(S)

    def block(args):
        qi, ci, i = args
        qpos = i * Q_BLOCK + jnp.arange(Q_BLOCK)
        s = jnp.einsum('bqhd,bkhd->bhqk', qi, kf) * scale
        s = s + ci[..., None] - c_k[:, :, None, :]
        causal = kpos[None, :] <= qpos[:, None]
        s = jnp.where(causal, s, NEG_INF)
        p = jax.nn.softmax(s, axis=-1)
        return jnp.einsum('bhqk,bkhd->bqhd', p, vf)

    out = lax.map(block, (qb, cb, jnp.arange(nb)))
    return out.transpose(1, 0, 2, 3, 4).reshape(B, S, H, D).astype(q.dtype)


def sliding_window_sink_attention(q, k, v, sinks, slopes):
    B, S, Hq, D = q.shape
    Hkv = k.shape[2]
    G = Hq // Hkv
    nb = S // WINDOW
    scale = D ** -0.5
    qb = q.astype(jnp.float32).reshape(B, nb, WINDOW, Hkv, G, D)

    def band(t):
        tb = t.astype(jnp.float32).reshape(B, nb, WINDOW, Hkv, D)
        prev = jnp.pad(tb[:, :-1], ((0, 0), (1, 0), (0, 0), (0, 0), (0, 0)))
        return jnp.concatenate([prev, tb], axis=2)

    kb, vb = band(k), band(v)
    s = jnp.einsum('bnqhgd,bnkhd->bnhgqk', qb, kb) * scale
    r = jnp.arange(WINDOW)[:, None]
    j = jnp.arange(2 * WINDOW)[None, :]
    dist = WINDOW + r - j
    in_window = (dist >= 0) & (dist < WINDOW)
    valid = in_window[None] & ((jnp.arange(nb)[:, None, None] > 0) | (j[None] >= WINDOW))
    alibi = -slopes.astype(jnp.float32).reshape(Hkv, G)[:, :, None, None] * dist.astype(jnp.float32)
    s = s + alibi[None, None]
    s = jnp.where(valid[None, :, None, None], s, NEG_INF)
    sink = jnp.broadcast_to(
        sinks.astype(jnp.float32).reshape(Hkv, G)[None, None, :, :, None, None],
        s.shape[:-1] + (1,))
    p = jax.nn.softmax(jnp.concatenate([s, sink], axis=-1), axis=-1)[..., :-1]
    out = jnp.einsum('bnhgqk,bnkhd->bnqhgd', p, vb)
    return out.reshape(B, S, Hq, D).astype(q.dtype)


def memory_attention(q, mk, mv):
    scale = q.shape[-1] ** -0.5
    s = jnp.einsum('bqhd,bmhd->bhqm', q.astype(jnp.float32), mk.astype(jnp.float32)) * scale
    p = jax.nn.softmax(s, axis=-1)
    return jnp.einsum('bhqm,bmhd->bqhd', p, mv.astype(jnp.float32)).astype(q.dtype)


def setup_inputs(seed: int = 0) -> dict:
    key = jax.random.key(seed)
    ks = jax.random.split(key, 32)
    f32 = jnp.float32

    def w(k, shape, fan_in):
        return jax.random.normal(k, shape, f32) * (fan_in ** -0.5)

    def gain(k, shape):
        return 1.0 + 0.02 * jax.random.normal(k, shape, f32)

    L = DEPTH
    return {
        "x": jax.random.normal(ks[0], (BATCH, SEQ, D_MODEL), f32),
        "mem": jax.random.normal(ks[1], (BATCH, MEM_LEN, D_MODEL), f32),
        "ffn1_norm": gain(ks[2], (L, D_MODEL)),
        "ffn1_gate": w(ks[3], (L, D_MODEL, D_FF), D_MODEL),
        "ffn1_up": w(ks[4], (L, D_MODEL, D_FF), D_MODEL),
        "ffn1_down": w(ks[5], (L, D_FF, D_MODEL), D_FF),
        "mix_norm": gain(ks[6], (L, D_MODEL)),
        "mem_norm": gain(ks[7], (L, D_MODEL)),
        "w_in": w(ks[8], (L, D_MODEL, IN_WIDTH), D_MODEL),
        "forget_bias": jax.random.uniform(ks[9], (L, FOX_HEADS), f32, 1.0, 4.0),
        "w_mem_k": w(ks[10], (L, D_MODEL, MEM_W), D_MODEL),
        "w_mem_v": w(ks[11], (L, D_MODEL, MEM_W), D_MODEL),
        "fox_q_gain": gain(ks[12], (L, HEAD_DIM)),
        "fox_k_gain": gain(ks[13], (L, HEAD_DIM)),
        "swa_q_gain": gain(ks[14], (L, HEAD_DIM)),
        "swa_k_gain": gain(ks[15], (L, HEAD_DIM)),
        "swa_sinks": jax.random.normal(ks[16], (L, SWA_HEADS), f32),
        "mem_q_gain": gain(ks[17], (L, HEAD_DIM)),
        "mem_k_gain": gain(ks[18], (L, HEAD_DIM)),
        "w_out": w(ks[19], (L, MIX_WIDTH, D_MODEL), MIX_WIDTH),
        "ffn2_norm": gain(ks[20], (L, D_MODEL)),
        "ffn2_gate": w(ks[21], (L, D_MODEL, D_FF), D_MODEL),
        "ffn2_up": w(ks[22], (L, D_MODEL, D_FF), D_MODEL),
        "ffn2_down": w(ks[23], (L, D_FF, D_MODEL), D_FF),
    }


def reference(x, mem, ffn1_norm, ffn1_gate, ffn1_up, ffn1_down, mix_norm, mem_norm, w_in,
              forget_bias, w_mem_k, w_mem_v, fox_q_gain, fox_k_gain, swa_q_gain, swa_k_gain,
              swa_sinks, mem_q_gain, mem_k_gain, w_out, ffn2_norm, ffn2_gate, ffn2_up, ffn2_down):
    B, S, _ = x.shape
    M = mem.shape[1]
    slopes = alibi_slopes(SWA_HEADS).astype(x.dtype)
    for l in range(DEPTH):
        x = x + 0.5 * swiglu(rms_norm(x, ffn1_norm[l]), ffn1_gate[l], ffn1_up[l], ffn1_down[l])

        h = rms_norm(x, mix_norm[l])
        proj = h @ w_in[l]
        fq, fk, fv, f_logit, sq, sk, sv, mq = jnp.split(proj, IN_CUTS, axis=-1)

        fq = rms_norm(fq.reshape(B, S, FOX_HEADS, HEAD_DIM), fox_q_gain[l])
        fk = rms_norm(fk.reshape(B, S, FOX_HEADS, HEAD_DIM), fox_k_gain[l])
        fv = fv.reshape(B, S, FOX_HEADS, HEAD_DIM)
        log_f = jax.nn.log_sigmoid(f_logit.astype(jnp.float32) + forget_bias[l].astype(jnp.float32))
        out_a = forgetting_attention(fq, fk, fv, log_f)

        sq = rms_norm(sq.reshape(B, S, SWA_HEADS, HEAD_DIM), swa_q_gain[l])
        sk = rms_norm(sk.reshape(B, S, SWA_KV_HEADS, HEAD_DIM), swa_k_gain[l])
        sv = sv.reshape(B, S, SWA_KV_HEADS, HEAD_DIM)
        out_b = sliding_window_sink_attention(sq, sk, sv, swa_sinks[l], slopes)

        mn = rms_norm(mem, mem_norm[l])
        mk = rms_norm((mn @ w_mem_k[l]).reshape(B, M, MEM_HEADS, HEAD_DIM), mem_k_gain[l])
        mv = (mn @ w_mem_v[l]).reshape(B, M, MEM_HEADS, HEAD_DIM)
        mq = rms_norm(mq.reshape(B, S, MEM_HEADS, HEAD_DIM), mem_q_gain[l])
        out_c = memory_attention(mq, mk, mv)

        mixed = jnp.concatenate([out_a.reshape(B, S, FOX_W), out_b.reshape(B, S, SWA_Q_W),
                                 out_c.reshape(B, S, MEM_W)], axis=-1)
        x = x + mixed @ w_out[l]

        x = x + 0.5 * swiglu(rms_norm(x, ffn2_norm[l]), ffn2_gate[l], ffn2_up[l], ffn2_down[l])
    return x
```

```cpp
#include <hip/hip_runtime.h>
#include <hip/hip_cooperative_groups.h>
#include <cstdio>
#include <cstdint>
namespace cg = cooperative_groups;
__device__ __forceinline__ int mk_lane() { int l; asm volatile("v_mbcnt_lo_u32_b32 %0, -1, 0\n\tv_mbcnt_hi_u32_b32 %0, -1, %0" : "=v"(l)); return l; }
typedef unsigned wt_u32x4 __attribute__((ext_vector_type(4)));
__device__ __forceinline__ void st16_wt(void* p, wt_u32x4 v) { asm volatile("global_store_dwordx4 %0, %1, off sc1\n\ts_nop 1" :: "v"(p), "v"(v) : "memory"); }
__device__ __forceinline__ void st16_pl(void* p, wt_u32x4 v) { *(wt_u32x4*)p = v; }
namespace pg8 {
#define PG8_LAS __attribute__((address_space(3)))
typedef unsigned short bf16_t;
typedef short bf16x8 __attribute__((ext_vector_type(8)));
typedef float f32x4 __attribute__((ext_vector_type(4)));
typedef unsigned u32x4 __attribute__((ext_vector_type(4)));
constexpr int BM = 256, BK = 64, HALF = 128, HTB = HALF * BK * 2  , STAGE_BYTES = 8 * HTB, NXCD = 8, WGM = 8;

__host__ __device__ __forceinline__ int lds_byte(int r, int c) { const int st = (r >> 4) * 2 + (c >> 5), rr = r & 15, cc = c & 31, ob = rr * 64 + cc * 2; return st * 1024 + (ob ^ (((ob >> 9) & 1) << 5)); }
__host__ __device__ __forceinline__ void stage_rc(int b, int& R, int& C) { const int st = b / 1024, sb = b % 1024, swz = sb ^ (((sb >> 9) & 1) << 5); R = (st >> 1) * 16 + swz / 64; C = (st & 1) * 32 + (swz % 64) / 2; }
__host__ __device__ __forceinline__ int perm32(int rho) { const int n = rho >> 4, i = rho & 15; return 8 * (i >> 2) + 4 * n + (i & 3); }

struct Unit { int pm, pn; };
struct Gemm { const bf16_t* A; const bf16_t* Bt; int M, N, K; };

struct StaticOrder {
    int nM, nN, nwg, G, c;
    __host__ __device__ void init(int M, int N, int G_, int c_) { nM = M / BM; nN = N / BM; nwg = nM * nN; G = G_; c = c_; }
    __host__ __device__ bool next(int i, Unit& u) const {
        const long L = (long)i * G + c; if (L >= nwg) return false;
        int wgid = (int)L; { const int q = nwg / NXCD, r = nwg % NXCD, xcd = wgid % NXCD, off = wgid / NXCD; wgid = (xcd < r ? xcd * (q + 1) : r * (q + 1) + (xcd - r) * q) + off; }
        const int nig = WGM * nN, gid = wgid / nig, fm = gid * WGM, gsz = (nM - fm) < WGM ? (nM - fm) : WGM;
        u.pm = fm + ((wgid % nig) % gsz); u.pn = (wgid % nig) / gsz; return true;
    }
    __device__ __forceinline__ void a_ready(const Unit&) const {}
    __device__ __forceinline__ void done(const Unit&) const {}
};

__device__ __forceinline__ unsigned cvt_pk_bf16(float lo, float hi) { unsigned r; asm volatile("v_cvt_pk_bf16_f32 %0, %1, %2" : "=v"(r) : "v"(lo), "v"(hi)); return r; }
typedef float f32x2 __attribute__((ext_vector_type(2)));

typedef float f32x2s __attribute__((ext_vector_type(2)));
__device__ __forceinline__ f32x2s silu_mul2(f32x2s g, f32x2s u) {
    const f32x2s t = g * (-1.4426950408889634f);
    f32x2s e; e.x = __builtin_amdgcn_exp2f(t.x); e.y = __builtin_amdgcn_exp2f(t.y);
    const f32x2s d = e + 1.0f;
    f32x2s r; r.x = __builtin_amdgcn_rcpf(d.x); r.y = __builtin_amdgcn_rcpf(d.y);
    return (g * u) * r;
}
struct EpiSwiglu {
    static constexpr bool PERM = true, AFTER_DRAIN = false;
    bf16_t* O; int ldc; const float* sumsq; float inv_n, eps;
    __device__ __forceinline__ void operator()(const f32x4 (&acc)[2][2][4][2], const Unit& u, int wr, int wc, int fr, int fq) const {
        const int row0 = u.pm * BM + wr * 64 + fr, col0 = u.pn * HALF + wc * 32 + 8 * fq;
#pragma unroll
        for (int ai = 0; ai < 2; ++ai)
#pragma unroll
            for (int m = 0; m < 4; ++m) { const int row = row0 + ai * HALF + m * 16;
                float rs = 1.f; if (sumsq) rs = 1.0f / sqrtf(sumsq[row] * inv_n + eps);
                const f32x4 g0 = acc[ai][0][m][0] * rs, g1 = acc[ai][0][m][1] * rs, u0 = acc[ai][1][m][0] * rs, u1 = acc[ai][1][m][1] * rs;
                const f32x2s a = silu_mul2((f32x2s){g0[0], g0[1]}, (f32x2s){u0[0], u0[1]}), b = silu_mul2((f32x2s){g0[2], g0[3]}, (f32x2s){u0[2], u0[3]});
                const f32x2s c = silu_mul2((f32x2s){g1[0], g1[1]}, (f32x2s){u1[0], u1[1]}), d = silu_mul2((f32x2s){g1[2], g1[3]}, (f32x2s){u1[2], u1[3]});
                u32x4 w; w.x = cvt_pk_bf16(a.x, a.y); w.y = cvt_pk_bf16(b.x, b.y); w.z = cvt_pk_bf16(c.x, c.y); w.w = cvt_pk_bf16(d.x, d.y);
                *(u32x4*)(O + (size_t)row * ldc + col0) = w; }
    }
};
template <bool WH, bool RB, bool OB, bool HALFSC> struct EpiResid {
    static constexpr bool PERM = true, AFTER_DRAIN = false; static constexpr int ldc = 2048; static constexpr float scale = HALFSC ? 0.5f : 1.0f;
    const float* res; const bf16_t* resb; float* out; bf16_t* outb; float* sumsq;
    __device__ __forceinline__ void operator()(const f32x4 (&acc)[2][2][4][2], const Unit& u, int wr, int wc, int fr, int fq) const {
        const int row0 = u.pm * BM + wr * 64 + fr, col0 = u.pn * BM + wc * 32 + 8 * fq;
        constexpr int MB = 4;
#pragma unroll
        for (int ai = 0; ai < 2; ++ai)
#pragma unroll
        for (int mb = 0; mb < 4; mb += MB) {
            f32x4 rv[MB][2][2]; u32x4 rb[MB][2];
#pragma unroll
            for (int m = 0; m < MB; ++m) { const size_t off = (size_t)(row0 + ai * HALF + (mb + m) * 16) * ldc + col0;
#pragma unroll
                for (int bj = 0; bj < 2; ++bj) { if (RB) rb[m][bj] = *(const u32x4*)(resb + off + bj * HALF);
                    else { rv[m][bj][0] = *(const f32x4*)(res + off + bj * HALF); rv[m][bj][1] = *(const f32x4*)(res + off + bj * HALF + 4); } } }
            asm volatile("" ::: "memory");
#pragma unroll
            for (int m = 0; m < MB; ++m) { const int row = row0 + ai * HALF + (mb + m) * 16; const size_t off = (size_t)row * ldc + col0; float ss = 0.f;
#pragma unroll
                for (int bj = 0; bj < 2; ++bj) {
                    f32x4 r0, r1;
                    if (RB) { const u32x4 w = rb[m][bj]; r0 = (f32x4){__uint_as_float(w.x << 16), __uint_as_float(w.x & 0xffff0000u), __uint_as_float(w.y << 16), __uint_as_float(w.y & 0xffff0000u)};
                                                   r1 = (f32x4){__uint_as_float(w.z << 16), __uint_as_float(w.z & 0xffff0000u), __uint_as_float(w.w << 16), __uint_as_float(w.w & 0xffff0000u)}; }
                    else { r0 = rv[m][bj][0]; r1 = rv[m][bj][1]; }
                    const f32x4 o0 = r0 + acc[ai][bj][mb + m][0] * scale, o1 = r1 + acc[ai][bj][mb + m][1] * scale;
                    if (OB) { u32x4 w; w.x = cvt_pk_bf16(o0[0], o0[1]); w.y = cvt_pk_bf16(o0[2], o0[3]); w.z = cvt_pk_bf16(o1[0], o1[1]); w.w = cvt_pk_bf16(o1[2], o1[3]); *(u32x4*)(outb + off + bj * HALF) = w; }
                    else { __builtin_nontemporal_store(o0, (f32x4*)(out + off + bj * HALF)); __builtin_nontemporal_store(o1, (f32x4*)(out + off + bj * HALF + 4)); }
                    if (WH) ss += ((o0[0] * o0[0] + o0[1] * o0[1]) + (o0[2] * o0[2] + o0[3] * o0[3])) + ((o1[0] * o1[0] + o1[1] * o1[1]) + (o1[2] * o1[2] + o1[3] * o1[3])); }
                if (WH) { ss += __shfl_xor(ss, 16); ss += __shfl_xor(ss, 32); if (fq == 0) atomicAdd(sumsq + row, ss); } }
            asm volatile("" ::: "memory"); }
    }
};
struct EpiNull {
    static constexpr bool PERM = false, AFTER_DRAIN = false; float* out;
    __device__ __forceinline__ void operator()(const f32x4 (&acc)[2][2][4][2], const Unit& u, int wr, int wc, int fr, int fq) const {
        float s = 0.f;
#pragma unroll
        for (int ai = 0; ai < 2; ++ai)
#pragma unroll
            for (int bj = 0; bj < 2; ++bj)
#pragma unroll
                for (int m = 0; m < 4; ++m)
#pragma unroll
                    for (int n = 0; n < 2; ++n) s += acc[ai][bj][m][n][0] + acc[ai][bj][m][n][1] + acc[ai][bj][m][n][2] + acc[ai][bj][m][n][3];
        if (s != s) out[u.pm * 7 + u.pn + wr + wc + fr + fq] = s;
    }
};
__device__ __forceinline__ float log_sigmoid(float x) { return x < 0.f ? x - log1pf(expf(x)) : -log1pf(expf(-x)); }
__device__ __forceinline__ void heads_store(const f32x4 (&acc)[2][2][4][2], int pm, int wr, int wc, int fr, int fq, PG8_LAS float* xch,
                                            const float* sumsq, float inv_n, float eps, bool nrm0, bool nrm1, const float* gain0, const float* gain1, bf16_t* O0, bf16_t* O1) {
    const int rl0 = wr * 64 + fr, col8 = wc * 32 + 8 * fq;
    float rs[2][4];
#pragma unroll
    for (int ai = 0; ai < 2; ++ai)
#pragma unroll
        for (int m = 0; m < 4; ++m) { const int rl = rl0 + ai * HALF + m * 16;
            rs[ai][m] = sumsq ? 1.0f / sqrtf(sumsq[pm * BM + rl] * inv_n + eps) : 1.f;
#pragma unroll
            for (int bj = 0; bj < 2; ++bj) { const f32x4 v0 = acc[ai][bj][m][0] * rs[ai][m], v1 = acc[ai][bj][m][1] * rs[ai][m];
                float ss = ((v0[0] * v0[0] + v0[1] * v0[1]) + (v0[2] * v0[2] + v0[3] * v0[3])) + ((v1[0] * v1[0] + v1[1] * v1[1]) + (v1[2] * v1[2] + v1[3] * v1[3]));
                ss += __shfl_xor(ss, 16); ss += __shfl_xor(ss, 32);
                if (fq == 0) xch[(rl * 2 + bj) * 4 + wc] = ss; } }
    asm volatile("s_waitcnt lgkmcnt(0)" ::: "memory"); __builtin_amdgcn_s_barrier(); asm volatile("" ::: "memory");
    f32x4 g[2][2];
#pragma unroll
    for (int n = 0; n < 2; ++n) { g[0][n] = nrm0 ? *(const f32x4*)(gain0 + col8 + 4 * n) : (f32x4){1.f, 1.f, 1.f, 1.f}; g[1][n] = nrm1 ? *(const f32x4*)(gain1 + col8 + 4 * n) : (f32x4){1.f, 1.f, 1.f, 1.f}; }
#pragma unroll
    for (int ai = 0; ai < 2; ++ai)
#pragma unroll
        for (int m = 0; m < 4; ++m) { const int rl = rl0 + ai * HALF + m * 16;
#pragma unroll
            for (int bj = 0; bj < 2; ++bj) { float sc = rs[ai][m];
                if (bj == 0 ? nrm0 : nrm1) { const f32x4 pp = *(const PG8_LAS f32x4*)(xch + (rl * 2 + bj) * 4); sc *= 1.0f / sqrtf(((pp[0] + pp[1]) + (pp[2] + pp[3])) * (1.f / 128.f) + eps); }
                const f32x4 s0 = g[bj][0] * sc, s1 = g[bj][1] * sc;
                const f32x4 v0 = acc[ai][bj][m][0] * s0, v1 = acc[ai][bj][m][1] * s1;
                u32x4 w; w.x = cvt_pk_bf16(v0[0], v0[1]); w.y = cvt_pk_bf16(v0[2], v0[3]); w.z = cvt_pk_bf16(v1[0], v1[1]); w.w = cvt_pk_bf16(v1[2], v1[3]);
                *(u32x4*)((bj == 0 ? O0 : O1) + (size_t)(pm * BM + rl) * 128 + col8) = w; } }
}
struct EpiInProj {
    static constexpr bool PERM = true, AFTER_DRAIN = false;
    bf16_t* HB; const float* sumsq; float inv_n, eps; int rows; PG8_LAS float* xch; const float* gt;
    __device__ __forceinline__ int gidx(int hh) const { return hh < 6 ? 0 : hh < 12 ? 1 : hh < 24 ? 2 : hh < 26 ? 3 : 4; }
    __device__ __forceinline__ bool nrm_of(int hh) const { return hh < 12 || (hh >= 18 && hh < 26) || hh >= 28; }
    __device__ __forceinline__ void operator()(const f32x4 (&acc)[2][2][4][2], const Unit& u, int wr, int wc, int fr, int fq) const {
        const int h0 = 2 * u.pn, h1 = h0 + 1;
        heads_store(acc, u.pm, wr, wc, fr, fq, xch, sumsq, inv_n, eps, nrm_of(h0), nrm_of(h1), gt + gidx(h0) * 128, gt + gidx(h1) * 128, HB + (size_t)h0 * rows * 128, HB + (size_t)h1 * rows * 128);
    }
};
struct EpiMemKV {
    static constexpr bool PERM = true, AFTER_DRAIN = false;
    bf16_t* O; int rows; float eps; PG8_LAS float* xch; const float* g_mk;
    __device__ __forceinline__ void operator()(const f32x4 (&acc)[2][2][4][2], const Unit& u, int wr, int wc, int fr, int fq) const {
        const int h0 = 2 * u.pn, h1 = h0 + 1; const bool nk = h0 < 4;
        heads_store(acc, u.pm, wr, wc, fr, fq, xch, nullptr, 0.f, eps, nk, nk, g_mk, g_mk, O + (size_t)h0 * rows * 128, O + (size_t)h1 * rows * 128);
    }
};

template <class Epi, class Sched, bool ALIGN_EPI = false, bool SP2 = false>
__device__ __forceinline__ void gemm_phase(PG8_LAS unsigned char* lds, const Gemm g, const Sched S, const Epi E, int wave_id) {
    const int lane = mk_lane(), wid = wave_id, tid = wid * 64 + lane, wr = wid >> 2, wc = wid & 3, fr = lane & 15, fq = lane >> 4;
    const int K = g.K, nt = K / BK;
    unsigned voffA[2], voffB[2];
#pragma unroll
    for (int i = 0; i < 2; ++i) { int R, C; stage_rc(tid * 16 + i * 8192, R, C); const int Rb = Epi::PERM ? ((R & ~31) + perm32(R & 31)) : R;
        voffA[i] = (unsigned)(R * K + C) * 2u; voffB[i] = (unsigned)(Rb * K + C) * 2u; }
    const size_t kstep = (size_t)(BK * 2);
    const size_t hstep = (size_t)HALF * K * 2;
    const size_t tstep = 2 * hstep;
    const unsigned ldsw = (unsigned)wid * 1024u;
    const int aoff = lds_byte(wr * 64 + fr, fq * 8), boff = lds_byte(wc * 32 + fr, fq * 8);
#define PG8_SA(b, h) (((b) * 2 + (h)) * HTB)
#define PG8_SB(b, h) ((4 + (b) * 2 + (h)) * HTB)
#define PG8_STAGE(bufoff, gbase, voff) do { _Pragma("unroll") for (int _i = 0; _i < 2; ++_i) \
        __builtin_amdgcn_global_load_lds((const unsigned*)((const char*)(gbase) + (voff)[_i]), (PG8_LAS unsigned*)(lds + (bufoff) + ldsw + _i * 8192), 16, 0, 0); } while (0)
#define PG8_LDA(dst, b, h) do { _Pragma("unroll") for (int m = 0; m < 4; ++m) _Pragma("unroll") for (int k = 0; k < 2; ++k) dst[m][k] = *(const PG8_LAS bf16x8*)(lds + PG8_SA(b, h) + aoff + m * 2048 + k * 1024); } while (0)
#define PG8_LDB(dst, b, h) do { _Pragma("unroll") for (int n = 0; n < 2; ++n) _Pragma("unroll") for (int k = 0; k < 2; ++k) dst[n][k] = *(const PG8_LAS bf16x8*)(lds + PG8_SB(b, h) + boff + n * 2048 + k * 1024); } while (0)
#define PG8_MMA(ai, bj, At, Bt) do { __builtin_amdgcn_s_setprio(1); _Pragma("unroll") for (int m = 0; m < 4; ++m) _Pragma("unroll") for (int n = 0; n < 2; ++n) _Pragma("unroll") for (int k = 0; k < 2; ++k) \
        acc[ai][bj][m][n] = __builtin_amdgcn_mfma_f32_16x16x32_bf16(Bt[n][k], At[m][k], acc[ai][bj][m][n], 0, 0, 0); __builtin_amdgcn_s_setprio(0); } while (0)
#define PG8_WAIT_V(n) asm volatile("s_waitcnt vmcnt(" #n ")" ::: "memory")
#define PG8_WAIT_L(n) asm volatile("s_waitcnt lgkmcnt(" #n ")" ::: "memory")
#define PG8_BAR __builtin_amdgcn_s_barrier()
#define PG8_SCHED __builtin_amdgcn_sched_barrier(0)
    Unit cur, nxt; int ui = 0;
    if (!S.next(0, cur)) return;
    f32x4 acc[2][2][4][2];
#pragma unroll
    for (int a = 0; a < 2; ++a)
#pragma unroll
        for (int b = 0; b < 2; ++b)
#pragma unroll
            for (int m = 0; m < 4; ++m)
#pragma unroll
                for (int n = 0; n < 2; ++n) acc[a][b][m][n] = (f32x4){0.f, 0.f, 0.f, 0.f};
    bf16x8 At[4][2], B0[2][2], B1[2][2];
    const char* cA = (const char*)g.A + (size_t)cur.pm * tstep; const char* cB = (const char*)g.Bt + (size_t)cur.pn * tstep;
    S.a_ready(cur);
    if constexpr (SP2) {
        PG8_STAGE(PG8_SB(0, 0), cB, voffB); PG8_STAGE(PG8_SB(0, 1), cB + hstep, voffB); PG8_STAGE(PG8_SA(0, 0), cA, voffA); PG8_STAGE(PG8_SA(0, 1), cA + hstep, voffA);
        if (wr == 1) PG8_BAR;
        PG8_WAIT_V(2); PG8_BAR;
        PG8_STAGE(PG8_SB(1, 0), cB + kstep, voffB); PG8_STAGE(PG8_SA(1, 0), cA + kstep, voffA); PG8_STAGE(PG8_SB(1, 1), cB + hstep + kstep, voffB);
        PG8_WAIT_V(6); PG8_BAR;
    } else {
        PG8_STAGE(PG8_SB(0, 0), cB, voffB); PG8_STAGE(PG8_SA(0, 0), cA, voffA); PG8_STAGE(PG8_SB(0, 1), cB + hstep, voffB); PG8_STAGE(PG8_SA(0, 1), cA + hstep, voffA);
        if (wr == 1) PG8_BAR;
        PG8_WAIT_V(4); PG8_BAR;
        PG8_STAGE(PG8_SB(1, 0), cB + kstep, voffB); PG8_STAGE(PG8_SA(1, 0), cA + kstep, voffA); PG8_STAGE(PG8_SB(1, 1), cB + hstep + kstep, voffB);
        PG8_WAIT_V(6); PG8_BAR;
    }
    for (;;) {
        const bool has_next = S.next(ui + 1, nxt);
        const char* nA = has_next ? (const char*)g.A + (size_t)nxt.pm * tstep : cA; const char* nB = has_next ? (const char*)g.Bt + (size_t)nxt.pn * tstep : cB;
        for (int t = 0; t < nt; t += 2) {
            const bool last = (t == nt - 2);
            const char* a1 = cA + (size_t)(t + 1) * kstep;
            const char* a2 = last ? nA : cA + (size_t)(t + 2) * kstep; const char* b2 = last ? nB : cB + (size_t)(t + 2) * kstep;
            const char* a3 = a2 + kstep; const char* b3 = b2 + kstep;
            if (last && has_next) S.a_ready(nxt);
            if constexpr (SP2) {
            PG8_LDB(B0, 0, 0); PG8_LDB(B1, 0, 1); PG8_SCHED; PG8_LDA(At, 0, 0); PG8_STAGE(PG8_SA(1, 1), a1 + hstep, voffA);
            PG8_WAIT_V(8); PG8_WAIT_L(0); PG8_BAR; PG8_MMA(0, 0, At, B0); PG8_MMA(0, 1, At, B1); PG8_BAR; PG8_SCHED;
            PG8_LDA(At, 0, 1); PG8_STAGE(PG8_SB(0, 0), b2, voffB); PG8_STAGE(PG8_SB(0, 1), b2 + hstep, voffB); PG8_STAGE(PG8_SA(0, 0), a2, voffA);
            PG8_WAIT_V(8); PG8_WAIT_L(0); PG8_BAR; PG8_MMA(1, 0, At, B0); PG8_MMA(1, 1, At, B1); PG8_BAR; PG8_SCHED;
            PG8_LDB(B0, 1, 0); PG8_LDB(B1, 1, 1); PG8_SCHED; PG8_LDA(At, 1, 0); PG8_STAGE(PG8_SA(0, 1), a2 + hstep, voffA);
            PG8_WAIT_V(8); PG8_WAIT_L(0); PG8_BAR; PG8_MMA(0, 0, At, B0); PG8_MMA(0, 1, At, B1); PG8_BAR; PG8_SCHED;
            PG8_LDA(At, 1, 1); PG8_STAGE(PG8_SB(1, 0), b3, voffB); PG8_STAGE(PG8_SB(1, 1), b3 + hstep, voffB); PG8_STAGE(PG8_SA(1, 0), a3, voffA);
            PG8_WAIT_V(8); PG8_WAIT_L(0); PG8_BAR; PG8_MMA(1, 0, At, B0); PG8_MMA(1, 1, At, B1); PG8_BAR; PG8_SCHED;
            } else {
            PG8_LDB(B0, 0, 0); PG8_SCHED; PG8_LDA(At, 0, 0); PG8_STAGE(PG8_SA(1, 1), a1 + hstep, voffA);
            PG8_WAIT_L(8); PG8_BAR; PG8_WAIT_L(0); PG8_MMA(0, 0, At, B0); PG8_BAR; PG8_SCHED;
            PG8_LDB(B1, 0, 1); PG8_STAGE(PG8_SB(0, 0), b2, voffB);
            PG8_BAR; PG8_WAIT_L(0); PG8_MMA(0, 1, At, B1); PG8_BAR;
            PG8_LDA(At, 0, 1); PG8_STAGE(PG8_SA(0, 0), a2, voffA);
            PG8_BAR; PG8_WAIT_L(0); PG8_MMA(1, 0, At, B0); PG8_BAR; PG8_SCHED;
            PG8_STAGE(PG8_SB(0, 1), b2 + hstep, voffB);
            PG8_WAIT_V(6); PG8_BAR; PG8_MMA(1, 1, At, B1); PG8_BAR;
            PG8_LDB(B0, 1, 0); PG8_SCHED; PG8_LDA(At, 1, 0); PG8_STAGE(PG8_SA(0, 1), a2 + hstep, voffA);
            PG8_WAIT_L(8); PG8_BAR; PG8_WAIT_L(0); PG8_MMA(0, 0, At, B0); PG8_BAR; PG8_SCHED;
            PG8_LDB(B1, 1, 1); PG8_STAGE(PG8_SB(1, 0), b3, voffB);
            PG8_BAR; PG8_WAIT_L(0); PG8_MMA(0, 1, At, B1); PG8_BAR;
            PG8_LDA(At, 1, 1); PG8_STAGE(PG8_SA(1, 0), a3, voffA);
            PG8_BAR; PG8_WAIT_L(0); PG8_MMA(1, 0, At, B0); PG8_BAR; PG8_SCHED;
            PG8_STAGE(PG8_SB(1, 1), b3 + hstep, voffB);
            PG8_WAIT_V(6); PG8_BAR; PG8_MMA(1, 1, At, B1); PG8_BAR;
            }
        }
        if constexpr (ALIGN_EPI) { if (wr == 0) PG8_BAR; }
        if constexpr (!Epi::AFTER_DRAIN) { E(acc, cur, wr, wc, fr, fq); S.done(cur); }
        if (!has_next) break;
#pragma unroll
        for (int a = 0; a < 2; ++a)
#pragma unroll
            for (int b = 0; b < 2; ++b)
#pragma unroll
                for (int m = 0; m < 4; ++m)
#pragma unroll
                    for (int n = 0; n < 2; ++n) acc[a][b][m][n] = (f32x4){0.f, 0.f, 0.f, 0.f};
        cur = nxt; cA = nA; cB = nB; ++ui;
        if constexpr (ALIGN_EPI) { if (wr == 1) PG8_BAR; }
    }
    PG8_WAIT_V(0);
    if constexpr (!ALIGN_EPI) { if (wr == 0) PG8_BAR; }
    PG8_BAR;
    if constexpr (Epi::AFTER_DRAIN) { E.fused(acc, cur, wr, wc, fr, fq, lds, wid, lane); S.done(cur); }
#undef PG8_SA
#undef PG8_SB
#undef PG8_STAGE
#undef PG8_LDA
#undef PG8_LDB
#undef PG8_MMA
#undef PG8_WAIT_V
#undef PG8_WAIT_L
#undef PG8_BAR
#undef PG8_SCHED
}
}

namespace att {
#define ATT_LAS __attribute__((address_space(3)))
typedef unsigned short bf16;
typedef short bf16x8 __attribute__((ext_vector_type(8)));
typedef short s16x4 __attribute__((ext_vector_type(4)));
typedef float f32x16 __attribute__((ext_vector_type(16)));
typedef float f32x4 __attribute__((ext_vector_type(4)));
typedef unsigned u32x4 __attribute__((ext_vector_type(4)));
constexpr int D = 128, NW = 8, QBLK = 32, KVBLK = 64, QB = NW * QBLK;
constexpr int SHM_V = KVBLK * D * 2, SHM_K = KVBLK * D * 2;
constexpr int LDS_WS_OFF = 2 * SHM_V + 2 * SHM_K, LDS_CK_OFF = LDS_WS_OFF + NW * 64 * 4, LDS_Q_OFF = LDS_CK_OFF + 4096 * 8, LDS_BYTES = LDS_Q_OFF;
constexpr float SCALE = 0.08838834764831845f, THR = 8.f, LOG2E = 1.4426950408889634f;
#ifndef OSTRIDE_T
#define OSTRIDE_T 2048
#endif
constexpr int OSTRIDE = OSTRIDE_T;

#define KSWZ(row, colB) ((row) * 256 + ((colB) ^ (((row) & 7) << 4)))
#define SBAR() __builtin_amdgcn_sched_barrier(0)
__device__ __forceinline__ int v_st(int k, int c) { const int kk = (k & ~0xC) | ((k & 4) << 1) | ((k & 8) >> 1); return ((kk >> 3) * 4 + (c >> 5)) * 512 + ((kk & 7) * 32 + (c & 31)) * 2; }
__device__ __forceinline__ int v_rd_base(int lane) { return ((lane & 3) << 3) | (((lane >> 2) & 3) << 6) | (((lane >> 4) & 1) << 5) | (((lane >> 5) & 1) << 8); }
constexpr int v_rd_off(int d0, int ks, int half) { return d0 * 512 + ks * 4096 + half * 2048; }
__device__ __forceinline__ int crow(int r, int hi) { return (r & 3) + 8 * (r >> 2) + 4 * hi; }
__device__ __forceinline__ unsigned cvtpk(float lo, float hi) { unsigned r; asm volatile("v_cvt_pk_bf16_f32 %0, %1, %2" : "=v"(r) : "v"(lo), "v"(hi)); return r; }
__device__ __forceinline__ bf16x8 load8(const bf16* p) { return *reinterpret_cast<const bf16x8*>(p); }
__device__ __forceinline__ void mask_tile(f32x16& p0, f32x16& p1, int dq, unsigned W) {
    const float NEG = -__builtin_inff();
#pragma unroll
    for (int r = 0; r < 16; ++r) { const int c = (r & 3) + 8 * (r >> 2);
        if ((unsigned)(dq - c) >= W) p0[r] = NEG;
        if ((unsigned)(dq - c - 32) >= W) p1[r] = NEG; }
}
typedef unsigned u32x2b __attribute__((ext_vector_type(2)));
__device__ __forceinline__ u32x2b bias_entry(float v) {
    const unsigned w0 = cvtpk(v, 0.f) & 0xffffu; const float r1 = v - __uint_as_float(w0 << 16);
    const unsigned w1 = cvtpk(r1, 0.f) & 0xffffu; const float r2 = r1 - __uint_as_float(w1 << 16);
    const unsigned w2 = cvtpk(r2, 0.f) & 0xffffu;
    return (u32x2b){w0 | (w1 << 16), w2};
}
__device__ __forceinline__ void partialSM(f32x16& p0, f32x16& p1, float& M, float& alpha, unsigned& md1, unsigned& md2) {
    float pmax = p0[0]; for (int r = 1; r < 16; ++r) pmax = fmaxf(pmax, p0[r]); for (int r = 0; r < 16; ++r) pmax = fmaxf(pmax, p1[r]);
    { auto rr = __builtin_amdgcn_permlane32_swap(__float_as_uint(pmax), __float_as_uint(pmax), false, false);
      pmax = fmaxf(__uint_as_float(rr[0]), __uint_as_float(rr[1])); }
    if (__builtin_expect(__all(pmax <= THR * LOG2E), 1)) { alpha = 1.f; }
    else { const float dl = fmaxf(pmax, 0.f); M += dl; alpha = __builtin_amdgcn_exp2f(-dl);
        for (int r = 0; r < 16; ++r) { p0[r] -= dl; p1[r] -= dl; }
        const u32x2b e = bias_entry(-M); md1 = 0x3F80u | (e.x << 16); md2 = (e.x >> 16) | (e.y << 16); }
    for (int r = 0; r < 16; ++r) p0[r] = __builtin_amdgcn_exp2f(p0[r]);
}
__device__ __forceinline__ void finishSM(f32x16& p0, f32x16& p1, float alpha, float& l_reg, bf16x8& pa0, bf16x8& pa1, bf16x8& pa2, bf16x8& pa3) {
    for (int r = 0; r < 16; ++r) p1[r] = __builtin_amdgcn_exp2f(p1[r]);
    typedef float f32x2p __attribute__((ext_vector_type(2)));
    f32x2p s2 = (f32x2p){p0[0], p0[1]} + (f32x2p){p1[0], p1[1]};
#pragma unroll
    for (int r = 2; r < 16; r += 2) { s2 += (f32x2p){p0[r], p0[r + 1]}; s2 += (f32x2p){p1[r], p1[r + 1]}; }
    float ps = s2.x + s2.y;
    { auto rr = __builtin_amdgcn_permlane32_swap(__float_as_uint(ps), __float_as_uint(ps), false, false);
      ps = __uint_as_float(rr[0]) + __uint_as_float(rr[1]); }
    l_reg = l_reg * alpha + ps;
#define PK4(P, B_, OUT) do { unsigned a0 = cvtpk(P[B_+0], P[B_+1]), a1 = cvtpk(P[B_+2], P[B_+3]);                          \
        unsigned b0 = cvtpk(P[B_+4], P[B_+5]), b1 = cvtpk(P[B_+6], P[B_+7]);                                             \
        auto r0 = __builtin_amdgcn_permlane32_swap(a0, b0, false, false); auto r1 = __builtin_amdgcn_permlane32_swap(a1, b1, false, false); \
        u32x4 w = {r0[0], r1[0], r0[1], r1[1]}; OUT = *reinterpret_cast<bf16x8*>(&w); } while (0)
    PK4(p0, 0, pa0); PK4(p0, 8, pa1); PK4(p1, 0, pa2); PK4(p1, 8, pa3);
#undef PK4
}
template <int KB>
__device__ __forceinline__ void qkt(f32x16& p0, f32x16& p1, const char* K_lds, int r32, int hi, const bf16x8* qr, const ATT_LAS char* nbp, unsigned md1, unsigned md2) {
    { const u32x2b e0 = *(const ATT_LAS u32x2b*)(nbp), e1 = *(const ATT_LAS u32x2b*)(nbp + 32 * 8);
      const u32x4 a0 = {e0.x, e0.y | 0x3F800000u, 0x3F803F80u, 0u}, a1 = {e1.x, e1.y | 0x3F800000u, 0x3F803F80u, 0u};
      const u32x4 on = {hi ? 0u : 0x3F803F80u, hi ? 0u : md1, hi ? 0u : md2, 0u};
      p0 = __builtin_amdgcn_mfma_f32_32x32x16_bf16(*reinterpret_cast<const bf16x8*>(&a0), *reinterpret_cast<const bf16x8*>(&on), f32x16{}, 0, 0, 0);
      p1 = __builtin_amdgcn_mfma_f32_32x32x16_bf16(*reinterpret_cast<const bf16x8*>(&a1), *reinterpret_cast<const bf16x8*>(&on), f32x16{}, 0, 0, 0); }
    const char* kb[4];
#pragma unroll
    for (int dd = 0; dd < 4; ++dd) kb[dd] = K_lds + KB * SHM_K + KSWZ(r32, (dd * 16 + hi * 8) * 2);
#pragma unroll
    for (int d0 = 0; d0 < 8; ++d0) { const char* a = kb[d0 & 3] + (d0 >> 2) * 128;
        bf16x8 b0 = *reinterpret_cast<const bf16x8*>(a);
        bf16x8 b1 = *reinterpret_cast<const bf16x8*>(a + 32 * 256);
        const bf16x8 q = qr[d0];
        p0 = __builtin_amdgcn_mfma_f32_32x32x16_bf16(b0, q, p0, 0, 0, 0);
        p1 = __builtin_amdgcn_mfma_f32_32x32x16_bf16(b1, q, p1, 0, 0, 0); }
}
template <int VB>
__device__ __forceinline__ void pv_tile(f32x16* o, int vb0, bf16x8 pa0, bf16x8 pa1, bf16x8 pa2, bf16x8 pa3) {
#define TRRD(dst, off) asm volatile("ds_read_b64_tr_b16 %0, %1 offset:%2" : "=&v"(dst) : "v"(vb0), "i"(off) : "memory")
#define PV_D0(d0) do { s16x4 l0, l1, l2, l3, h0, h1, h2, h3; constexpr int b_ = VB * SHM_V + v_rd_off(d0, 0, 0); \
        TRRD(l0, b_); TRRD(h0, b_ + 2048); TRRD(l1, b_ + 4096); TRRD(h1, b_ + 6144); TRRD(l2, b_ + 8192); TRRD(h2, b_ + 10240); TRRD(l3, b_ + 12288); TRRD(h3, b_ + 14336); \
        asm volatile("s_waitcnt lgkmcnt(0)" ::: "memory"); SBAR(); \
        o[d0] = __builtin_amdgcn_mfma_f32_32x32x16_bf16(pa0, (bf16x8){l0[0], l0[1], l0[2], l0[3], h0[0], h0[1], h0[2], h0[3]}, o[d0], 0, 0, 0);   \
        o[d0] = __builtin_amdgcn_mfma_f32_32x32x16_bf16(pa1, (bf16x8){l1[0], l1[1], l1[2], l1[3], h1[0], h1[1], h1[2], h1[3]}, o[d0], 0, 0, 0);   \
        o[d0] = __builtin_amdgcn_mfma_f32_32x32x16_bf16(pa2, (bf16x8){l2[0], l2[1], l2[2], l2[3], h2[0], h2[1], h2[2], h2[3]}, o[d0], 0, 0, 0);   \
        o[d0] = __builtin_amdgcn_mfma_f32_32x32x16_bf16(pa3, (bf16x8){l3[0], l3[1], l3[2], l3[3], h3[0], h3[1], h3[2], h3[3]}, o[d0], 0, 0, 0); } while (0)
    PV_D0(0); PV_D0(1); PV_D0(2); PV_D0(3);
#undef PV_D0
#undef TRRD
}

struct BlockRef { const bf16* Q; const bf16* K; const bf16* V; bf16* O; const float* ck; int P0, W, skv, mode; float sl, sinkl2; };
struct Seam { bf16x8 qr[8]; bf16x8 st_v0, st_v1, st_k0, st_k1; };
__device__ __forceinline__ int swa_jlo(int P0, int W) { const int lowk = P0 - W + 1; return lowk > 0 ? lowk / KVBLK : 0; }
#define ROW(p, k0, rr) ((p) + (size_t)((k0) + (rr)) * D + sc)
#define VMW() asm volatile("s_waitcnt vmcnt(0)" ::: "memory")
#define VMWN(n) asm volatile("s_waitcnt vmcnt(%0)" :: "i"(n) : "memory")
#define SLOAD_H(Kp, Vp, k0) do { S.st_v0 = load8(ROW(Vp, k0, sr)); S.st_v1 = load8(ROW(Vp, k0, 32 + sr));              \
                         S.st_k0 = load8(ROW(Kp, k0, sr)); S.st_k1 = load8(ROW(Kp, k0, 32 + sr)); } while (0)
#define SWRITE_HK(bf) do { *(bf16x8*)(K_lds + (bf) * SHM_K + kws) = S.st_k0; *(bf16x8*)(K_lds + (bf) * SHM_K + kws + 32 * 256) = S.st_k1; } while (0)
#define SWRITE_HV(bf) do { *(bf16x8*)(V_lds + (bf) * SHM_V + vst0) = S.st_v0; *(bf16x8*)(V_lds + (bf) * SHM_V + vst1) = S.st_v1; } while (0)
#define SWRITE_H(bf) do { SWRITE_HV(bf); SWRITE_HK(bf); } while (0)
__device__ __forceinline__ void attn_prime(const BlockRef& cur, char* lds, Seam& S, int wave_id) {
    const int lane = mk_lane(), wid = wave_id, tid = wid * 64 + lane, r32 = lane & 31, hi = lane >> 5;
    const int sr = tid >> 4, sc = (tid & 15) * 8, kws = KSWZ(sr, sc * 2); char* K_lds = lds + 2 * SHM_V;
    const int kb0 = swa_jlo(cur.P0, cur.W) * KVBLK;
    for (int d0 = 0; d0 < 8; ++d0) S.qr[d0] = load8(cur.Q + (size_t)(wid * QBLK + r32) * D + d0 * 16 + hi * 8);
    SLOAD_H(cur.K, cur.V, kb0); VMW(); SWRITE_HK(0);
    __syncthreads();
}
__device__ __forceinline__ void attn_block(const BlockRef& cur, const BlockRef& nxt, char* lds, Seam& S, int wave_id) {
    const int lane = mk_lane(), wid = wave_id, tid = wid * 64 + lane, r32 = lane & 31, hi = lane >> 5;
    const int W = cur.W, mode = cur.mode, skv = cur.skv;
    const int j_lo = swa_jlo(cur.P0, W);
    int j_hi = (cur.P0 + QB - 1) / KVBLK + 1; if (j_hi > skv / KVBLK) j_hi = skv / KVBLK;
    const int NT = j_hi - j_lo;
    const int kbn = swa_jlo(nxt.P0, nxt.W) * KVBLK;
    const int qlo = cur.P0 + wid * QBLK, qm = qlo + r32 - 4 * hi;
    char* V_lds = lds; char* K_lds = lds + 2 * SHM_V;
    float* ws = (float*)(lds + LDS_WS_OFF) + wid * 64; float* li_l = ws, * al_l = ws + 32;
    const ATT_LAS float* ckl = (const ATT_LAS float*)(lds + LDS_CK_OFF);
    {
        ATT_LAS u32x2b* nb = (ATT_LAS u32x2b*)(lds + LDS_CK_OFF); const int nk = NT * KVBLK;
        if (mode == 0) {
            float* wt = (float*)(lds + LDS_WS_OFF); const bool actv = tid * 8 < nk;
            f32x4 a = {0.f, 0.f, 0.f, 0.f}, b = {0.f, 0.f, 0.f, 0.f};
            if (actv) { a = *(const f32x4*)(cur.ck + tid * 8); b = *(const f32x4*)(cur.ck + tid * 8 + 4); }
            a.y += a.x; a.z += a.y; a.w += a.z; b.x += a.w; b.y += b.x; b.z += b.y; b.w += b.z;
            float xs = b.w;
#pragma unroll
            for (int o_ = 1; o_ < 64; o_ <<= 1) { const float y = __shfl_up(xs, o_); if (lane >= o_) xs += y; }
            if (lane == 63) wt[wid] = xs;
            __syncthreads();
            float off = xs - b.w;
            for (int w2 = 0; w2 < wid; ++w2) off += wt[w2];
            a = a + off; b = b + off;
            if (tid * 8 == cur.P0) wt[8] = a.x;
            __syncthreads();
            const float cref = wt[8], k = LOG2E;
            if (actv) { const f32x4 va = (cref - a) * k, vb = (cref - b) * k;
#pragma unroll
                for (int i = 0; i < 4; ++i) { nb[tid * 8 + i] = bias_entry(va[i]); nb[tid * 8 + 4 + i] = bias_entry(vb[i]); } } }
        else { const float sl_ = (mode == 1) ? cur.sl : 0.f;
            for (int i = tid; i < nk; i += 512) nb[i] = bias_entry(sl_ * (float)(j_lo * KVBLK + i - cur.P0)); }
        __syncthreads();
    }
    const ATT_LAS char* nbl = (const ATT_LAS char*)(lds + LDS_CK_OFF) + r32 * 8;
    float m_reg = 0.f, l_reg = 0; unsigned md1 = 0x3F80u, md2 = 0u; f32x16 o[4] = {};
    const int sr = tid >> 4, sc = (tid & 15) * 8, vst0 = v_st(sr, sc), vst1 = v_st(32 + sr, sc), kws = KSWZ(sr, sc * 2);
    const int vb0 = (int)(uintptr_t)V_lds + v_rd_base(lane);
    const bf16* Kh = cur.K; const bf16* Vh = cur.V;
#define RESC(a) do { if (__any((a) < 1.f)) { if (hi == 0) al_l[r32] = (a); asm volatile("s_waitcnt lgkmcnt(0)" ::: "memory");              \
                     for (int d_ = 0; d_ < 4; ++d_) for (int r = 0; r < 16; ++r) o[d_][r] *= al_l[crow(r, hi)]; } } while (0)
#define KBASE(t) ((j_lo + (t)) * KVBLK)
#define MASKT(P0_, P1_, t) do { const int kb_ = KBASE(t); \
        if (kb_ + KVBLK - 1 > qlo || kb_ <= qlo + QBLK - 1 - W) mask_tile(P0_, P1_, qm - kb_, (unsigned)W); } while (0)
    constexpr int NQL = 8;
#define SEAM_K0() do { VMWN(NQL); SWRITE_HK(0); SBAR(); } while (0)
    f32x16 pA0, pA1, pB0, pB1; float alA, alB; bf16x8 pa0, pa1, pa2, pa3;
    SWRITE_HV(0); SBAR();
    if (NT > 1) { SLOAD_H(Kh, Vh, KBASE(1)); }
    SBAR(); qkt<0>(pA0, pA1, K_lds, r32, hi, S.qr, nbl, md1, md2);
    MASKT(pA0, pA1, 0); partialSM(pA0, pA1, m_reg, alA, md1, md2);
    if (NT > 1) { VMW(); SWRITE_H(1); }
    __syncthreads();
#define HALF_STEP(PX0, PX1, alX, PY0, PY1, alY, t, KB, VB, SB) do {                                                      \
        SBAR(); if ((t) + 1 < NT) { SLOAD_H(Kh, Vh, KBASE((t) + 1)); SBAR(); }     \
        qkt<KB>(PX0, PX1, K_lds, r32, hi, S.qr, nbl + (t) * (KVBLK * 8), md1, md2);                                                                    \
        finishSM(PY0, PY1, alY, l_reg, pa0, pa1, pa2, pa3); SBAR();                                                           \
        pv_tile<VB>(o, vb0, pa0, pa1, pa2, pa3); MASKT(PX0, PX1, (t)); partialSM(PX0, PX1, m_reg, alX, md1, md2);                  \
        __syncthreads();                                                                                                      \
        if ((t) + 1 < NT) { VMW(); SWRITE_H(SB); }                                                                            \
        RESC(alX); __syncthreads(); } while (0)
    for (int t = 1; t + 1 < NT; t += 2) {
        HALF_STEP(pB0, pB1, alB, pA0, pA1, alA, t, 1, 0, 0);
        HALF_STEP(pA0, pA1, alA, pB0, pB1, alB, t + 1, 0, 1, 1);
    }
    const bool even = (NT & 1) == 0;
    if (even) { SBAR(); qkt<1>(pB0, pB1, K_lds, r32, hi, S.qr, nbl + (NT - 1) * (KVBLK * 8), md1, md2); SBAR(); }
    SLOAD_H(nxt.K, nxt.V, kbn); SBAR();
#pragma unroll
    for (int d0 = 0; d0 < 8; ++d0) S.qr[d0] = load8(nxt.Q + (size_t)(wid * QBLK + r32) * D + d0 * 16 + hi * 8);
    SBAR();
    finishSM(pA0, pA1, alA, l_reg, pa0, pa1, pa2, pa3); SBAR();
    pv_tile<0>(o, vb0, pa0, pa1, pa2, pa3);
    if (even) { MASKT(pB0, pB1, NT - 1); partialSM(pB0, pB1, m_reg, alB, md1, md2); __syncthreads(); RESC(alB);
        finishSM(pB0, pB1, alB, l_reg, pa0, pa1, pa2, pa3); SBAR(); pv_tile<1>(o, vb0, pa0, pa1, pa2, pa3); }
    SBAR(); SEAM_K0();
    { float lfin = l_reg;
#ifndef TEST_NOSINK
 if (mode == 1) lfin += __builtin_amdgcn_exp2f(cur.sinkl2 + cur.sl * (float)(qlo + r32 - cur.P0) - m_reg);
#endif

      if (hi == 0) li_l[r32] = lfin; }
    asm volatile("s_waitcnt lgkmcnt(0)" ::: "memory");
    float rli[16];
#pragma unroll
    for (int r = 0; r < 16; ++r) rli[r] = __builtin_amdgcn_rcpf(li_l[crow(r, hi)]);
    bf16* Ow = cur.O + (size_t)(wid * QBLK) * OSTRIDE;
#pragma unroll
    for (int r = 0; r < 16; ++r) { const int orow = crow(r, hi);
#pragma unroll
        for (int d0 = 0; d0 < 4; ++d0) { const float v = o[d0][r] * rli[r];
            const float vn = __shfl_xor(v, 1);
            if ((r32 & 1) == 0) *(unsigned*)(Ow + (size_t)orow * OSTRIDE + d0 * 32 + r32) = cvtpk(v, vn); } }
    __syncthreads();
#undef RESC
#undef KBASE
#undef MASKT
#undef SEAM_K0
#undef HALF_STEP
}
#undef ROW
#undef VMW
#undef VMWN
#undef SLOAD_H
#undef SWRITE_HK
#undef SWRITE_HV
#undef SWRITE_H
#undef SBAR
#undef KSWZ
}


#define LAS __attribute__((address_space(3)))
typedef unsigned short bf16;
typedef unsigned v4u __attribute__((ext_vector_type(4)));
typedef float f32x4 __attribute__((ext_vector_type(4)));
constexpr int NBATCH = 4, SEQ = 4096, DM = 2048, T = NBATCH * SEQ, DFF = 5632, HD = 128, MEMLEN = 256, MROWS = NBATCH * MEMLEN;
constexpr int INW = 4102, NIN = 4096, NUP = 2 * DFF;
constexpr float EPS = 1e-6f;
constexpr size_t MiB = 1u << 20;
constexpr size_t WS_BAR = 1 * MiB, BAR_BYTES = 16384; constexpr int MEMFLAG = 3520;
constexpr size_t WS_SS1 = 0, WS_SS2 = 64 * 1024, WS_LOGF = 128 * 1024, WS_CUM = 512 * 1024, WS_GT = 960 * 1024;
constexpr size_t WS_BT_UP1 = 2 * MiB, WS_BT_DN1 = WS_BT_UP1 + 44 * MiB, WS_BT_UP2 = WS_BT_DN1 + 22 * MiB, WS_BT_DN2 = WS_BT_UP2 + 44 * MiB;
constexpr size_t WS_BT_IN = WS_BT_DN2 + 22 * MiB, WS_BT_OUT = WS_BT_IN + 17 * MiB, WS_BT_MEM = WS_BT_OUT + 8 * MiB;
constexpr size_t WS_MN = WS_BT_MEM + 4 * MiB, WS_MKV = WS_MN + 4 * MiB;
constexpr size_t WS_A = WS_MKV + 2 * MiB;
constexpr size_t WS_B = WS_A + 176 * MiB;
constexpr size_t WS_C = WS_B + 64 * MiB;
constexpr size_t WS_END = WS_C + 64 * MiB;
static_assert(WS_END <= 512 * MiB, "d_ws map");
constexpr int LDS_BYTES = 155648;
static_assert(att::LDS_BYTES <= LDS_BYTES, "attention scratch inside the LDS allocation");

__device__ __forceinline__ unsigned f2bf(float f) { unsigned u = __builtin_bit_cast(unsigned, f); return (u + 0x7fffu + ((u >> 16) & 1u)) >> 16; }
__device__ __forceinline__ unsigned pk2(float lo, float hi) { return f2bf(lo) | (f2bf(hi) << 16); }
__device__ __forceinline__ float bflo(unsigned w) { return __uint_as_float(w << 16); }
__device__ __forceinline__ float bfhi(unsigned w) { return __uint_as_float(w & 0xffff0000u); }
__device__ __forceinline__ float wave_sum(float v) {
#pragma unroll
    for (int o = 1; o < 64; o <<= 1) v += __shfl_xor(v, o);
    return v;
}
#define LDS_WAIT() asm volatile("s_waitcnt lgkmcnt(0)" ::: "memory")

__device__ __forceinline__ void tr_item(const float* __restrict__ W, int ldw, int k0, int n0, int nvalid, bf16* WT, int K, int r0, LAS float* scr, int lane) {
    const int c = lane & 31;
    float v[32];
    const float* src = W + (size_t)(k0 + (lane >> 5)) * ldw + n0 + c;
#pragma unroll
    for (int i = 0; i < 32; ++i) { v[i] = 0.f; if (c < nvalid) v[i] = src[(size_t)(2 * i) * ldw]; }
#pragma unroll
    for (int i = 0; i < 32; ++i) scr[(2 * i + (lane >> 5)) * 33 + c] = v[i];
    LDS_WAIT(); asm volatile("" ::: "memory");
    const int c8 = lane & 7;
#pragma unroll
    for (int j = 0; j < 4; ++j) { const int n = (lane >> 3) + 8 * j; const LAS float* s = scr + (8 * c8) * 33 + n;
        v4u o; o.x = pk2(s[0 * 33], s[1 * 33]); o.y = pk2(s[2 * 33], s[3 * 33]); o.z = pk2(s[4 * 33], s[5 * 33]); o.w = pk2(s[6 * 33], s[7 * 33]);
        *(v4u*)(WT + (size_t)(r0 + n) * K + k0 + 8 * c8) = o; }
    LDS_WAIT(); asm volatile("" ::: "memory");
}
__device__ __forceinline__ void tr_matrix_item(const float* W, int ldw, int K, bf16* WT, int nblk, int kind, int item, LAS float* scr, int lane) {
    const int kb = item / nblk, blk = item % nblk; int n0 = 32 * blk, r0 = 32 * blk, nvalid = 32;
    if (kind == 1) r0 = 256 * (blk >> 2) + 32 * (blk & 3);
    else if (kind == 2) r0 = 256 * (blk >> 2) + 32 * (blk & 3) + 128;
    else if (kind == 3) { if (blk < 128) { const int hh = blk >> 2; n0 = (hh < 18 ? hh * 128 : 2310 + (hh - 18) * 128) + 32 * (blk & 3); }
                          else { n0 = 2304; nvalid = 6; } }
    else if (kind == 4) r0 = 512 + 32 * blk;
    tr_item(W, ldw, 64 * kb, n0, nvalid, WT, K, r0, scr, lane);
}

struct TrItem { const float* src; size_t step; bf16* dst; int K; bool ok; const float* gk; };
__device__ __forceinline__ TrItem tr_decode(const float* W, int ldw, int K, bf16* WT, int nblk, int kind, int item, int lane, const float* gain = nullptr) {
    const int kb = item / nblk, blk = item % nblk; int n0 = 32 * blk, r0 = 32 * blk, nvalid = 32;
    if (kind == 1) r0 = 256 * (blk >> 2) + 32 * (blk & 3);
    else if (kind == 2) r0 = 256 * (blk >> 2) + 32 * (blk & 3) + 128;
    else if (kind == 3) { if (blk < 128) { const int hh = blk >> 2; n0 = (hh < 18 ? hh * 128 : 2310 + (hh - 18) * 128) + 32 * (blk & 3); } else { n0 = 2304; nvalid = 6; } }
    else if (kind == 4) r0 = 512 + 32 * blk;
    const int c = lane & 31; TrItem t;
    t.src = W + (size_t)(64 * kb + (lane >> 5)) * ldw + n0 + c; t.step = (size_t)2 * ldw; t.dst = WT + (size_t)r0 * K + 64 * kb; t.K = K; t.ok = c < nvalid; t.gk = gain ? gain + 64 * kb : nullptr;
    return t;
}
__device__ __forceinline__ void tr_load(const TrItem& t, float (&v)[32]) {
#pragma unroll
    for (int i = 0; i < 32; ++i) { v[i] = 0.f; if (t.ok) v[i] = t.src[(size_t)i * t.step]; }
}
__device__ __forceinline__ void tr_store(const TrItem& t, const float (&v)[32], LAS float* scr, int lane) {
    const int c = lane & 31;
#pragma unroll
    for (int i = 0; i < 32; ++i) scr[(2 * i + (lane >> 5)) * 33 + c] = v[i];
    LDS_WAIT(); asm volatile("" ::: "memory");
    const int c8 = lane & 7;
    f32x4 g0 = {1.f, 1.f, 1.f, 1.f}, g1 = g0; if (t.gk) { g0 = *(const f32x4*)(t.gk + 8 * c8); g1 = *(const f32x4*)(t.gk + 8 * c8 + 4); }
#pragma unroll
    for (int j = 0; j < 4; ++j) { const int n = (lane >> 3) + 8 * j; const LAS float* s = scr + (8 * c8) * 33 + n;
        v4u o; o.x = pk2(s[0 * 33] * g0.x, s[1 * 33] * g0.y); o.y = pk2(s[2 * 33] * g0.z, s[3 * 33] * g0.w); o.z = pk2(s[4 * 33] * g1.x, s[5 * 33] * g1.y); o.w = pk2(s[6 * 33] * g1.z, s[7 * 33] * g1.w);
        *(v4u*)(t.dst + (size_t)n * t.K + 8 * c8) = o; }
    LDS_WAIT(); asm volatile("" ::: "memory");
}
__device__ __forceinline__ void rms_row(const float* xrow, const float* g, bf16* orow, int lane) {
    const f32x4* xr = (const f32x4*)xrow + lane; f32x4 v[8]; float s = 0.f;
#pragma unroll
    for (int j = 0; j < 8; ++j) { v[j] = xr[64 * j]; s += (v[j].x * v[j].x + v[j].y * v[j].y) + (v[j].z * v[j].z + v[j].w * v[j].w); }
    const float rstd = 1.0f / sqrtf(wave_sum(s) * (1.f / DM) + EPS);
    unsigned long long* o8 = (unsigned long long*)orow + lane; const f32x4* gr = (const f32x4*)g + lane;
#pragma unroll
    for (int j = 0; j < 8; ++j) { const f32x4 gv = gr[64 * j]; const f32x4 o = v[j] * rstd * gv;
        o8[64 * j] = (unsigned long long)pk2(o.x, o.y) | ((unsigned long long)pk2(o.z, o.w) << 32); }
}


#define XB_TMO      128
#define XB_XCNT(j)  (256  + 64 * (j))
#define XB_XSUB(j)  (1280 + 64 * (j))
#define XB_XGEN(j)  (2304 + 64 * (j))
#define XB_TOP      3328
#define XB_TOPGEN   3392
#define XCD_BAR_WORDS 3456
#define XB_SPIN_CAP (1u << 18)
__device__ __forceinline__ unsigned xb_ld(unsigned* p)              { return __hip_atomic_load(p, __ATOMIC_RELAXED, __HIP_MEMORY_SCOPE_AGENT); }
__device__ __forceinline__ unsigned xb_add(unsigned* p, unsigned v) { return __hip_atomic_fetch_add(p, v, __ATOMIC_RELAXED, __HIP_MEMORY_SCOPE_AGENT); }
__device__ __forceinline__ unsigned xb_xcc_id() { return (unsigned)__builtin_amdgcn_s_getreg((3 << 11) | 20) & 0xFu; }
#define XB_SPIN(cond, bar) do { unsigned _sp = 0; while (cond) { __builtin_amdgcn_s_sleep(1); \
    if ((++_sp & 255u) == 0u) { if (xb_ld(&(bar)[XB_TMO])) break; if (_sp > XB_SPIN_CAP) { atomicAdd(&(bar)[XB_TMO], 1u); break; } } } } while (0)
__device__ __forceinline__ void xcd_barrier_complete(unsigned* bar, unsigned x, unsigned& nloc, unsigned& nx) {
    const unsigned G = gridDim.x * gridDim.y * gridDim.z;
    unsigned sum, cnt, mine, sp = 0u;
    for (;;) {
        sum = 0u; cnt = 0u; mine = 0u;
#pragma unroll
        for (unsigned j = 0; j < 16; ++j) { const unsigned c = xb_ld(&bar[XB_XCNT(j)]); sum += c; cnt += (c > 0u) ? 1u : 0u; mine = (j == x) ? c : mine; }
        if (sum == G) break;
        __builtin_amdgcn_s_sleep(1);
        if ((++sp & 255u) == 0u) { if (xb_ld(&bar[XB_TMO])) break; if (sp > XB_SPIN_CAP) { atomicAdd(&bar[XB_TMO], 1u); break; } }
    }
    nloc = mine > 0u ? mine : 1u; nx = cnt > 0u ? cnt : 1u;
}
__device__ __forceinline__ void xcd_barrier(unsigned* bar, volatile LAS unsigned* st, int wave) {
    asm volatile("s_waitcnt vmcnt(0)" ::: "memory");
    __syncthreads();
    if (wave == 0 && mk_lane() == 0) {
        const unsigned x = xb_xcc_id();
        __builtin_amdgcn_s_waitcnt(0);
        unsigned nloc = st[0], nx = st[1];
        if (nloc == 0u) { xcd_barrier_complete(bar, x, nloc, nx); st[0] = nloc; st[1] = nx; }
        const unsigned old = xb_add(&bar[XB_XSUB(x)], 1u);
        const unsigned gen = old / nloc;
        if (old + 1u == (gen + 1u) * nloc) {
            __builtin_amdgcn_fence(__ATOMIC_RELEASE, "agent");
            asm volatile("s_waitcnt vmcnt(0)" ::: "memory");
            const unsigned og = xb_add(&bar[XB_TOP], 1u);
            const unsigned tg = og / nx;
            if (og + 1u == (tg + 1u) * nx) xb_add(&bar[XB_TOPGEN], 1u);
            else XB_SPIN(xb_ld(&bar[XB_TOPGEN]) == tg, bar);
            __builtin_amdgcn_fence(__ATOMIC_ACQUIRE, "agent");
            xb_add(&bar[XB_XGEN(x)], 1u);
            asm volatile("s_waitcnt vmcnt(0)" ::: "memory");
        } else {
            XB_SPIN(xb_ld(&bar[XB_XGEN(x)]) == gen, bar);
            __builtin_amdgcn_fence(__ATOMIC_ACQUIRE, "agent");
            asm volatile("s_waitcnt vmcnt(0)" ::: "memory");
        }
    }
    __syncthreads();
}

__device__ __forceinline__ void cvt_row(const float* xrow, bf16* orow, float* ss_out, int lane) {
    const f32x4* xr = (const f32x4*)xrow + lane; f32x4 v[8]; float s = 0.f;
#pragma unroll
    for (int j = 0; j < 8; ++j) { v[j] = xr[64 * j]; s += (v[j].x * v[j].x + v[j].y * v[j].y) + (v[j].z * v[j].z + v[j].w * v[j].w); }
    s = wave_sum(s); if (lane == 0) *ss_out = s;
    unsigned long long* o8 = (unsigned long long*)orow + lane;
#pragma unroll
    for (int j = 0; j < 8; ++j) o8[64 * j] = (unsigned long long)pk2(v[j].x, v[j].y) | ((unsigned long long)pk2(v[j].z, v[j].w) << 32);
}

struct Params { const float* in[24]; float* out; unsigned char* ws; };
enum { I_X = 0, I_MEM, I_F1N, I_F1G, I_F1U, I_F1D, I_MIXN, I_MEMN, I_WIN, I_FB, I_WMK, I_WMV, I_FQG, I_FKG, I_SQG, I_SKG, I_SINK, I_MQG, I_MKG, I_WOUT, I_F2N, I_F2G, I_F2U, I_F2D };


__device__ __forceinline__ void get_block(int v, int i, att::BlockRef& r, const bf16* HB, const bf16* MKV, bf16* MIX, const float* CUM, const float* sinks) {
    r.ck = CUM; r.sl = 0.f; r.sinkl2 = 0.f;
    if (v < 192 && i < 2) { const int bh = v >> 3, x = v & 7, qb = (i == 0) ? x : 15 - x, b = bh / 6, h = bh % 6; const size_t row0 = (size_t)b * SEQ;
        r.Q = HB + ((size_t)h * T + row0 + qb * 256) * HD; r.K = HB + ((size_t)(6 + h) * T + row0) * HD; r.V = HB + ((size_t)(12 + h) * T + row0) * HD;
        r.O = MIX + (row0 + qb * 256) * DM + h * HD; r.P0 = qb * 256; r.W = 1 << 20; r.skv = SEQ; r.mode = 0; r.ck = CUM + (size_t)bh * SEQ; }
    else { const int u = v - 192; int s0, ns, m0;
        if (v < 192) { s0 = 0; ns = 0; m0 = 160 + v - 2; }
        else if (u < 16) { s0 = 4 * u; ns = 4; m0 = 4 * u; }
        else if (u < 48) { s0 = 64 + 7 * (u - 16); ns = 7; m0 = 64 + (u - 16); }
        else { s0 = 288 + 6 * (u - 48); ns = 6; m0 = 96 + 4 * (u - 48); }
        if (i < ns) { const int sb = s0 + i, bhs = sb >> 4, qb = sb & 15, b = bhs / 6, h = bhs % 6, kvh = h / 3; const size_t row0 = (size_t)b * SEQ;
            r.Q = HB + ((size_t)(18 + h) * T + row0 + qb * 256) * HD; r.K = HB + ((size_t)(24 + kvh) * T + row0) * HD; r.V = HB + ((size_t)(26 + kvh) * T + row0) * HD;
            r.O = MIX + (row0 + qb * 256) * DM + (6 + h) * HD; r.P0 = qb * 256; r.W = 128; r.skv = SEQ; r.mode = 1;
            r.sl = exp2f(-8.0f * (float)(h + 1) / 6.0f) * att::LOG2E; r.sinkl2 = sinks[h] * att::LOG2E; }
        else { const int mb = m0 + (i - ns), bhm = mb >> 4, qb = mb & 15, b = bhm >> 2, h = bhm & 3; const size_t row0 = (size_t)b * SEQ;
            r.Q = HB + ((size_t)(28 + h) * T + row0 + qb * 256) * HD; r.K = MKV + ((size_t)h * MROWS + b * MEMLEN) * HD; r.V = MKV + ((size_t)(4 + h) * MROWS + b * MEMLEN) * HD;
            r.O = MIX + (row0 + qb * 256) * DM + (12 + h) * HD; r.P0 = 256; r.W = 1 << 20; r.skv = MEMLEN; r.mode = 2; } }
}

#define PHASE_PTRS unsigned char* ws = p.ws; asm volatile("" : "+s"(ws)); \
    float* SS1 = (float*)(ws + WS_SS1); float* SS2 = (float*)(ws + WS_SS2); float* LOGF = (float*)(ws + WS_LOGF); float* CUM = (float*)(ws + WS_CUM); \
    bf16* BT_UP1 = (bf16*)(ws + WS_BT_UP1); bf16* BT_DN1 = (bf16*)(ws + WS_BT_DN1); bf16* BT_UP2 = (bf16*)(ws + WS_BT_UP2); bf16* BT_DN2 = (bf16*)(ws + WS_BT_DN2); \
    bf16* BT_IN = (bf16*)(ws + WS_BT_IN); bf16* BT_OUT = (bf16*)(ws + WS_BT_OUT); bf16* BT_MEM = (bf16*)(ws + WS_BT_MEM); \
    bf16* MN = (bf16*)(ws + WS_MN); bf16* MKV = (bf16*)(ws + WS_MKV); \
    bf16* ACT = (bf16*)(ws + WS_A); bf16* HB = (bf16*)(ws + WS_A); bf16* HBUF = (bf16*)(ws + WS_B); bf16* MIX = (bf16*)(ws + WS_B); bf16* H2 = (bf16*)(ws + WS_C); bf16* X1B = (bf16*)(ws + WS_C); bf16* X2B = (bf16*)(ws + WS_BT_UP1);    \
    const float* x = p.in[I_X]; float* out = p.out; \
    (void)SS1; (void)SS2; (void)LOGF; (void)CUM; (void)BT_UP1; (void)BT_DN1; (void)BT_UP2; (void)BT_DN2; (void)BT_IN; (void)BT_OUT; (void)BT_MEM; (void)MN; (void)MKV; (void)ACT; (void)HB; (void)HBUF; (void)MIX; (void)H2; (void)X1B; (void)X2B; (void)x; (void)out; unsigned* BAR = (unsigned*)(ws + WS_BAR); (void)BAR;
#ifndef REP_P0
#define REP_P0 1
#endif
#ifndef REP_S1
#define REP_S1 1
#endif
#ifndef REP_S4
#define REP_S4 1
#endif
#ifndef REP_S3
#define REP_S3 1
#endif
#ifndef REP_LOGITS
#define REP_LOGITS 1
#endif
#ifndef REP_SYNC
#define REP_SYNC 0
#endif
__global__ void __launch_bounds__(512, 2) fwd_megakernel(Params p) {
    extern __shared__ __attribute__((aligned(16))) unsigned char lds_raw[];
    cg::grid_group grid = cg::this_grid();
    LAS unsigned char* lds = (LAS unsigned char*)lds_raw;
    const int wave = __builtin_amdgcn_readfirstlane((int)threadIdx.x >> 6);
    const int G = gridDim.x, bx = blockIdx.x;
    volatile LAS unsigned* BST = (volatile LAS unsigned*)(lds + LDS_BYTES - 16);
    { unsigned char* ws = p.ws; asm volatile("" : "+s"(ws)); unsigned* BAR = (unsigned*)(ws + WS_BAR);
    if (wave == 0 && mk_lane() == 0) { BST[0] = 0u; BST[1] = 0u; (void)xb_add(&BAR[XB_XCNT(xb_xcc_id())], 1u); } }
#define GRID_BAR() do { unsigned char* wsb_ = p.ws; asm volatile("" : "+s"(wsb_)); xcd_barrier((unsigned*)(wsb_ + WS_BAR), BST, wave); } while (0)

#ifndef ONLY_S4
    for (int rep_ = 0; rep_ < REP_P0; ++rep_)
    {   PHASE_PTRS
        const int lane = mk_lane(), tid = wave * 64 + lane;
        for (int i = bx * 512 + tid; i < 2 * T; i += G * 512) SS1[i] = 0.f;
        if (bx == 0 && tid < 128) { float* GT = (float*)(ws + WS_GT);
            const float qs = att::SCALE * att::LOG2E;
            GT[tid] = p.in[I_FQG][tid] * qs; GT[128 + tid] = p.in[I_FKG][tid]; GT[256 + tid] = p.in[I_SQG][tid] * qs; GT[384 + tid] = p.in[I_SKG][tid]; GT[512 + tid] = p.in[I_MQG][tid] * qs; }
        LAS float* scr = (LAS float*)(lds + wave * 16384);
        const int gw = bx * 8 + wave, NGW = G * 8;
        constexpr int NB_UP = DFF / 32, NB_DM = DM / 32, NB_IN = NIN / 32 + 1, NB_MEM = 512 / 32;
        constexpr int I_GU = (DM / 64) * NB_UP, I_DN = (DFF / 64) * NB_DM, I_IN = (DM / 64) * NB_IN, I_OUT = (DM / 64) * NB_DM, I_MM = (DM / 64) * NB_MEM;
        constexpr int NITEMS = 4 * I_GU + 2 * I_DN + I_IN + I_OUT + 2 * I_MM;
#define P0_DECODE(it_) ([&]() -> TrItem { int r = (it_); \
            if (r < I_GU) return tr_decode(p.in[I_F1G], DFF, DM, BT_UP1, NB_UP, 1, r, lane); r -= I_GU; \
            if (r < I_GU) return tr_decode(p.in[I_F1U], DFF, DM, BT_UP1, NB_UP, 2, r, lane); r -= I_GU; \
            if (r < I_DN) return tr_decode(p.in[I_F1D], DM, DFF, BT_DN1, NB_DM, 0, r, lane); r -= I_DN; \
            if (r < I_IN) return tr_decode(p.in[I_WIN], INW, DM, BT_IN, NB_IN, 3, r, lane, p.in[I_MIXN]); r -= I_IN; \
            if (r < I_MM) return tr_decode(p.in[I_WMK], 512, DM, BT_MEM, NB_MEM, 0, r, lane); r -= I_MM; \
            if (r < I_MM) return tr_decode(p.in[I_WMV], 512, DM, BT_MEM, NB_MEM, 4, r, lane); r -= I_MM; \
            if (r < I_OUT) return tr_decode(p.in[I_WOUT], DM, DM, BT_OUT, NB_DM, 0, r, lane); r -= I_OUT; \
            if (r < I_GU) return tr_decode(p.in[I_F2G], DFF, DM, BT_UP2, NB_UP, 1, r, lane, p.in[I_F2N]); r -= I_GU; \
            if (r < I_GU) return tr_decode(p.in[I_F2U], DFF, DM, BT_UP2, NB_UP, 2, r, lane, p.in[I_F2N]); r -= I_GU; \
            return tr_decode(p.in[I_F2D], DM, DFF, BT_DN2, NB_DM, 0, r, lane); })()
        if (gw < NITEMS) {
            TrItem cur = P0_DECODE(gw); float va[32], vb[32]; tr_load(cur, va);
            for (int it = gw; it < NITEMS; it += 2 * NGW) {
                const int i1 = it + NGW, i2 = it + 2 * NGW; TrItem n1 = cur, n2 = cur;
                if (i1 < NITEMS) { n1 = P0_DECODE(i1); tr_load(n1, vb); }
                tr_store(cur, va, scr, lane);
                if (i1 < NITEMS) { if (i2 < NITEMS) { n2 = P0_DECODE(i2); tr_load(n2, va); } tr_store(n1, vb, scr, lane); cur = n2; }
            }
        }
#undef P0_DECODE
        for (int m = gw; m < T + MROWS; m += NGW) {
            if (m < T) rms_row(x + (size_t)m * DM, p.in[I_F1N], HBUF + (size_t)m * DM, lane);
            else rms_row(p.in[I_MEM] + (size_t)(m - T) * DM, p.in[I_MEMN], MN + (size_t)(m - T) * DM, lane);
        }
    }
    GRID_BAR();
    if (p.ws == nullptr) grid.sync();

    for (int rep_ = 0; rep_ < REP_S1; ++rep_)
    {   PHASE_PTRS
        pg8::Gemm g{HBUF, BT_UP1, T, NUP, DM}; pg8::StaticOrder S; S.init(T, NUP, G, bx);
        pg8::EpiSwiglu E{ACT, DFF, nullptr, 1.f / DM, EPS};
        pg8::gemm_phase<pg8::EpiSwiglu, pg8::StaticOrder, true, true>(lds, g, S, E, wave);
    }
    GRID_BAR();

    {   PHASE_PTRS
        pg8::Gemm g{ACT, BT_DN1, T, DM, DFF}; pg8::StaticOrder S; S.init(T, DM, G, bx);
        pg8::EpiResid<true, false, true, true> E{x, nullptr, nullptr, X1B, SS1};
        pg8::gemm_phase<pg8::EpiResid<true, false, true, true>, pg8::StaticOrder, true, true>(lds, g, S, E, wave);
    }
    GRID_BAR();

    for (int rep_ = 0; rep_ < REP_S3; ++rep_)
    {   PHASE_PTRS
#ifndef TEST_NOLOGITS
        for (int repl_ = 0; repl_ < REP_LOGITS; ++repl_)
        {
            typedef short bf16x8 __attribute__((ext_vector_type(8)));
            const int lane = mk_lane(); LAS f32x4* red = (LAS f32x4*)lds;
            for (int rb = bx * 4 + (wave & 3); rb < T / 16; rb += G * 4) {
                const int kh = wave >> 2;
                const bf16* ap = X1B + (size_t)(rb * 16 + (lane & 15)) * DM + kh * 1024 + (lane >> 4) * 8;
                const bf16* bp = BT_IN + (size_t)(4096 + (lane & 15)) * DM + kh * 1024 + (lane >> 4) * 8;
                f32x4 acc = {0.f, 0.f, 0.f, 0.f};
#pragma unroll 16
                for (int ks = 0; ks < 32; ++ks) { const bf16x8 av = *(const bf16x8*)(ap + ks * 32), bv = *(const bf16x8*)(bp + ks * 32);
                    acc = __builtin_amdgcn_mfma_f32_16x16x32_bf16(av, bv, acc, 0, 0, 0); }
                if (kh == 1) red[(wave & 3) * 64 + lane] = acc;
                __syncthreads();
                if (kh == 0) { acc += red[(wave & 3) * 64 + lane]; const int h = lane & 15;
                    if (h < 6) { const float fb = p.in[I_FB][h];
#pragma unroll
                        for (int r = 0; r < 4; ++r) { const int row = rb * 16 + 4 * (lane >> 4) + r; const float rs = 1.0f / sqrtf(SS1[row] * (1.f / DM) + EPS);
                            LOGF[(size_t)((row >> 12) * 6 + h) * SEQ + (row & 4095)] = pg8::log_sigmoid(acc[r] * rs + fb); } } }
                __syncthreads();
            }
        }
#endif
#ifdef PROBE_S3FULL
        {   pg8::Gemm g0{X1B, BT_IN, T, NIN, DM}; pg8::StaticOrder S0; S0.init(T, NIN, G, bx);
            pg8::EpiInProj E0{(bf16*)out, SS1, 1.f / DM, EPS, T, (LAS float*)(lds + 131072), (const float*)(ws + WS_GT)};
            pg8::gemm_phase<pg8::EpiInProj, pg8::StaticOrder, true, true>(lds, g0, S0, E0, wave); }
#endif
#ifdef PROBE_S3NULL
        {   pg8::Gemm g0{X1B, BT_IN, T, NIN, DM}; pg8::StaticOrder S0; S0.init(T, NIN, G, bx);
            pg8::EpiNull E0{(float*)(ws + WS_B)};
            pg8::gemm_phase<pg8::EpiNull, pg8::StaticOrder, true, true>(lds, g0, S0, E0, wave); }
#endif
        pg8::Gemm g{X1B, BT_IN, T, NIN, DM}; pg8::StaticOrder S; S.init(T, NIN, G, bx);
        pg8::EpiInProj E{HB, SS1, 1.f / DM, EPS, T, (LAS float*)(lds + 131072), (const float*)(ws + WS_GT)};
        pg8::gemm_phase<pg8::EpiInProj, pg8::StaticOrder, true, true>(lds, g, S, E, wave);
    }
    GRID_BAR();

#endif
#ifndef NO_S4
    for (int rep_ = 0; rep_ < REP_S4; ++rep_)
    {   PHASE_PTRS
        att::Seam S; char* alds = (char*)lds_raw;
        const int vcu = (G % 8 == 0) ? (bx % 8) * (G / 8) + bx / 8 : bx;
        for (int v = vcu; v < 256; v += G) if (v >= 192 && v < 208) {
            pg8::Gemm g2{MN, BT_MEM, MROWS, 1024, DM}; pg8::StaticOrder S2; S2.init(MROWS, 1024, 16, v - 192);
            pg8::EpiMemKV E2{MKV, MROWS, EPS, (LAS float*)(lds + 131072), p.in[I_MKG]};
            pg8::gemm_phase<pg8::EpiMemKV, pg8::StaticOrder, true, true>(lds, g2, S2, E2, wave);
            asm volatile("s_waitcnt vmcnt(0)" ::: "memory"); __syncthreads();
            if (wave == 0 && mk_lane() == 0) { __builtin_amdgcn_fence(__ATOMIC_RELEASE, "agent"); asm volatile("s_waitcnt vmcnt(0)" ::: "memory"); (void)xb_add(&BAR[MEMFLAG], 1u); }
        }
        for (int v = vcu; v < 256; v += G) {
            const int u_ = v - 192, ns_ = u_ < 16 ? 4 : (u_ < 48 ? 7 : 6), n = v < 192 ? 2 : (u_ < 16 ? 8 : (u_ < 48 ? 8 : 10));
#define S4_MEMWAIT() do { if (wave == 0 && mk_lane() == 0) { XB_SPIN(xb_ld(&BAR[MEMFLAG]) < 16u, BAR); __builtin_amdgcn_fence(__ATOMIC_ACQUIRE, "agent"); asm volatile("s_waitcnt vmcnt(0)" ::: "memory"); } __syncthreads(); } while (0)
            { att::BlockRef c0; get_block(v, 0, c0, HB, MKV, MIX, LOGF, p.in[I_SINK]); att::attn_prime(c0, alds, S, wave); }
            for (int i = 0; i < n; ++i) {
                if (v >= 192 && i == ns_ - 1) S4_MEMWAIT();
                att::BlockRef cur, nxt; get_block(v, i, cur, HB, MKV, MIX, LOGF, p.in[I_SINK]);
                get_block(v, (i + 1 < n) ? i + 1 : i, nxt, HB, MKV, MIX, LOGF, p.in[I_SINK]);
                att::attn_block(cur, nxt, alds, S, wave);
            }
            if (v < 96) {
                S4_MEMWAIT();
                att::BlockRef c2; get_block(v, 2, c2, HB, MKV, MIX, LOGF, p.in[I_SINK]); att::attn_prime(c2, alds, S, wave);
                att::attn_block(c2, c2, alds, S, wave);
            }
#undef S4_MEMWAIT
        }
    }
#endif
    GRID_BAR();

#ifndef ONLY_S4
    for (int rep_ = 0; rep_ < REP_SYNC; ++rep_) GRID_BAR();
    {   PHASE_PTRS
        pg8::Gemm g{MIX, BT_OUT, T, DM, DM}; pg8::StaticOrder S; S.init(T, DM, G, bx);
        pg8::EpiResid<true, true, true, false> E{nullptr, X1B, nullptr, X2B, SS2};
        pg8::gemm_phase<pg8::EpiResid<true, true, true, false>, pg8::StaticOrder, true, true>(lds, g, S, E, wave);
    }
    GRID_BAR();

    {   PHASE_PTRS
        pg8::Gemm g{X2B, BT_UP2, T, NUP, DM}; pg8::StaticOrder S; S.init(T, NUP, G, bx);
        pg8::EpiSwiglu E{ACT, DFF, SS2, 1.f / DM, EPS};
        pg8::gemm_phase<pg8::EpiSwiglu, pg8::StaticOrder, true, true>(lds, g, S, E, wave);
    }
    GRID_BAR();

    {   PHASE_PTRS
        pg8::Gemm g{ACT, BT_DN2, T, DM, DFF}; pg8::StaticOrder S; S.init(T, DM, G, bx);
        pg8::EpiResid<false, true, false, true> E{nullptr, X2B, out, nullptr, nullptr};
        pg8::gemm_phase<pg8::EpiResid<false, true, false, true>, pg8::StaticOrder, true, true>(lds, g, S, E, wave);
    }
#endif
}

extern "C" void kernel_launch(void* const* d_in, const int* in_sizes, int n_in, void* d_out, int out_size, void* d_ws, size_t ws_size, hipStream_t stream) {
    static int grid = 0;
    if (grid == 0) {
        if (n_in != 24 || in_sizes[0] != T * DM || out_size != T * DM || ws_size < WS_END) { fprintf(stderr, "kernel_launch: shape/workspace mismatch (n_in %d, in0 %d, out %d, ws %zu)\n", n_in, n_in > 0 ? in_sizes[0] : -1, out_size, ws_size); grid = -1; return; }
        int dev = 0, cus = 0, per_cu = 0;
        (void)hipGetDevice(&dev); (void)hipDeviceGetAttribute(&cus, hipDeviceAttributeMultiprocessorCount, dev);
        if (hipFuncSetAttribute((const void*)fwd_megakernel, hipFuncAttributeMaxDynamicSharedMemorySize, LDS_BYTES) != hipSuccess) fprintf(stderr, "kernel_launch: hipFuncSetAttribute failed\n");
        if (hipOccupancyMaxActiveBlocksPerMultiprocessor(&per_cu, (const void*)fwd_megakernel, 512, LDS_BYTES) != hipSuccess || per_cu < 1) { per_cu = 1; (void)hipGetLastError(); }
        if (cus <= 0) cus = 256;
        grid = cus * per_cu; if (grid > 256) grid = 256;
    }
    if (grid < 0) return;
    if (hipMemsetAsync((char*)d_ws + WS_BAR, 0, BAR_BYTES, stream) != hipSuccess) { fprintf(stderr, "kernel_launch: hipMemsetAsync failed\n"); return; }
    Params p{};
    for (int i = 0; i < 24; ++i) p.in[i] = (const float*)d_in[i];
    p.out = (float*)d_out; p.ws = (unsigned char*)d_ws;
    void* args[] = {&p};
    hipError_t e = hipLaunchCooperativeKernel((const void*)fwd_megakernel, dim3(grid), dim3(512), args, LDS_BYTES, stream);
    if (e != hipSuccess) fprintf(stderr, "cooperative launch failed: %s (grid %d)\n", hipGetErrorString(e), grid);
}
```

```cpp
#include <hip/hip_runtime.h>
#include <hip/hip_cooperative_groups.h>
#include <cstdio>
#include <cstdint>
namespace cg = cooperative_groups;
__device__ __forceinline__ int mk_lane() { int l; asm volatile("v_mbcnt_lo_u32_b32 %0, -1, 0\n\tv_mbcnt_hi_u32_b32 %0, -1, %0" : "=v"(l)); return l; }
typedef unsigned wt_u32x4 __attribute__((ext_vector_type(4)));
__device__ __forceinline__ void st16_wt(void* p, wt_u32x4 v) { asm volatile("global_store_dwordx4 %0, %1, off sc1\n\ts_nop 1" :: "v"(p), "v"(v) : "memory"); }
__device__ __forceinline__ void st16_pl(void* p, wt_u32x4 v) { *(wt_u32x4*)p = v; }
namespace pg8 {
#define PG8_LAS __attribute__((address_space(3)))
typedef unsigned short bf16_t;
typedef short bf16x8 __attribute__((ext_vector_type(8)));
typedef float f32x4 __attribute__((ext_vector_type(4)));
typedef unsigned u32x4 __attribute__((ext_vector_type(4)));
constexpr int BM = 256, BK = 64, HALF = 128, HTB = HALF * BK * 2  , STAGE_BYTES = 8 * HTB, NXCD = 8, WGM = 8;

__host__ __device__ __forceinline__ int lds_byte(int r, int c) { const int st = (r >> 4) * 2 + (c >> 5), rr = r & 15, cc = c & 31, ob = rr * 64 + cc * 2; return st * 1024 + (ob ^ (((ob >> 9) & 1) << 5)); }
__host__ __device__ __forceinline__ void stage_rc(int b, int& R, int& C) { const int st = b / 1024, sb = b % 1024, swz = sb ^ (((sb >> 9) & 1) << 5); R = (st >> 1) * 16 + swz / 64; C = (st & 1) * 32 + (swz % 64) / 2; }
__host__ __device__ __forceinline__ int perm32(int rho) { const int n = rho >> 4, i = rho & 15; return 8 * (i >> 2) + 4 * n + (i & 3); }

struct Unit { int pm, pn; };
struct Gemm { const bf16_t* A; const bf16_t* Bt; int M, N, K; };

struct StaticOrder {
    int nM, nN, nwg, G, c;
    __host__ __device__ void init(int M, int N, int G_, int c_) { nM = M / BM; nN = N / BM; nwg = nM * nN; G = G_; c = c_; }
    __host__ __device__ bool next(int i, Unit& u) const {
        const long L = (long)i * G + c; if (L >= nwg) return false;
        int wgid = (int)L; { const int q = nwg / NXCD, r = nwg % NXCD, xcd = wgid % NXCD, off = wgid / NXCD; wgid = (xcd < r ? xcd * (q + 1) : r * (q + 1) + (xcd - r) * q) + off; }
        const int nig = WGM * nN, gid = wgid / nig, fm = gid * WGM, gsz = (nM - fm) < WGM ? (nM - fm) : WGM;
        u.pm = fm + ((wgid % nig) % gsz); u.pn = (wgid % nig) / gsz; return true;
    }
    __device__ __forceinline__ void a_ready(const Unit&) const {}
    __device__ __forceinline__ void done(const Unit&) const {}
};

__device__ __forceinline__ unsigned cvt_pk_bf16(float lo, float hi) { unsigned r; asm volatile("v_cvt_pk_bf16_f32 %0, %1, %2" : "=v"(r) : "v"(lo), "v"(hi)); return r; }
typedef float f32x2 __attribute__((ext_vector_type(2)));

typedef float f32x2s __attribute__((ext_vector_type(2)));
__device__ __forceinline__ f32x2s silu_mul2(f32x2s g, f32x2s u) {
    const f32x2s t = g * (-1.4426950408889634f);
    f32x2s e; e.x = __builtin_amdgcn_exp2f(t.x); e.y = __builtin_amdgcn_exp2f(t.y);
    const f32x2s d = e + 1.0f;
    f32x2s r; r.x = __builtin_amdgcn_rcpf(d.x); r.y = __builtin_amdgcn_rcpf(d.y);
    return (g * u) * r;
}
struct EpiSwiglu {
    static constexpr bool PERM = true, AFTER_DRAIN = false;
    bf16_t* O; int ldc; const float* sumsq; float inv_n, eps;
    __device__ __forceinline__ void operator()(const f32x4 (&acc)[2][2][4][2], const Unit& u, int wr, int wc, int fr, int fq) const {
        const int row0 = u.pm * BM + wr * 64 + fr, col0 = u.pn * HALF + wc * 32 + 8 * fq;
#pragma unroll
        for (int ai = 0; ai < 2; ++ai)
#pragma unroll
            for (int m = 0; m < 4; ++m) { const int row = row0 + ai * HALF + m * 16;
                float rs = 1.f; if (sumsq) rs = 1.0f / sqrtf(sumsq[row] * inv_n + eps);
                const f32x4 g0 = acc[ai][0][m][0] * rs, g1 = acc[ai][0][m][1] * rs, u0 = acc[ai][1][m][0] * rs, u1 = acc[ai][1][m][1] * rs;
                const f32x2s a = silu_mul2((f32x2s){g0[0], g0[1]}, (f32x2s){u0[0], u0[1]}), b = silu_mul2((f32x2s){g0[2], g0[3]}, (f32x2s){u0[2], u0[3]});
                const f32x2s c = silu_mul2((f32x2s){g1[0], g1[1]}, (f32x2s){u1[0], u1[1]}), d = silu_mul2((f32x2s){g1[2], g1[3]}, (f32x2s){u1[2], u1[3]});
                u32x4 w; w.x = cvt_pk_bf16(a.x, a.y); w.y = cvt_pk_bf16(b.x, b.y); w.z = cvt_pk_bf16(c.x, c.y); w.w = cvt_pk_bf16(d.x, d.y);
                *(u32x4*)(O + (size_t)row * ldc + col0) = w; }
    }
};
template <bool WH, bool RB, bool OB, bool HALFSC> struct EpiResid {
    static constexpr bool PERM = true, AFTER_DRAIN = false; static constexpr int ldc = 2048; static constexpr float scale = HALFSC ? 0.5f : 1.0f;
    const float* res; const bf16_t* resb; float* out; bf16_t* outb; float* sumsq;
    __device__ __forceinline__ void operator()(const f32x4 (&acc)[2][2][4][2], const Unit& u, int wr, int wc, int fr, int fq) const {
        const int row0 = u.pm * BM + wr * 64 + fr, col0 = u.pn * BM + wc * 32 + 8 * fq;
        constexpr int MB = 4;
#pragma unroll
        for (int ai = 0; ai < 2; ++ai)
#pragma unroll
        for (int mb = 0; mb < 4; mb += MB) {
            f32x4 rv[MB][2][2]; u32x4 rb[MB][2];
#pragma unroll
            for (int m = 0; m < MB; ++m) { const size_t off = (size_t)(row0 + ai * HALF + (mb + m) * 16) * ldc + col0;
#pragma unroll
                for (int bj = 0; bj < 2; ++bj) { if (RB) rb[m][bj] = *(const u32x4*)(resb + off + bj * HALF);
                    else { rv[m][bj][0] = *(const f32x4*)(res + off + bj * HALF); rv[m][bj][1] = *(const f32x4*)(res + off + bj * HALF + 4); } } }
            asm volatile("" ::: "memory");
#pragma unroll
            for (int m = 0; m < MB; ++m) { const int row = row0 + ai * HALF + (mb + m) * 16; const size_t off = (size_t)row * ldc + col0; float ss = 0.f;
#pragma unroll
                for (int bj = 0; bj < 2; ++bj) {
                    f32x4 r0, r1;
                    if (RB) { const u32x4 w = rb[m][bj]; r0 = (f32x4){__uint_as_float(w.x << 16), __uint_as_float(w.x & 0xffff0000u), __uint_as_float(w.y << 16), __uint_as_float(w.y & 0xffff0000u)};
                                                   r1 = (f32x4){__uint_as_float(w.z << 16), __uint_as_float(w.z & 0xffff0000u), __uint_as_float(w.w << 16), __uint_as_float(w.w & 0xffff0000u)}; }
                    else { r0 = rv[m][bj][0]; r1 = rv[m][bj][1]; }
                    const f32x4 o0 = r0 + acc[ai][bj][mb + m][0] * scale, o1 = r1 + acc[ai][bj][mb + m][1] * scale;
                    if (OB) { u32x4 w; w.x = cvt_pk_bf16(o0[0], o0[1]); w.y = cvt_pk_bf16(o0[2], o0[3]); w.z = cvt_pk_bf16(o1[0], o1[1]); w.w = cvt_pk_bf16(o1[2], o1[3]); *(u32x4*)(outb + off + bj * HALF) = w; }
                    else { __builtin_nontemporal_store(o0, (f32x4*)(out + off + bj * HALF)); __builtin_nontemporal_store(o1, (f32x4*)(out + off + bj * HALF + 4)); }
                    if (WH) ss += ((o0[0] * o0[0] + o0[1] * o0[1]) + (o0[2] * o0[2] + o0[3] * o0[3])) + ((o1[0] * o1[0] + o1[1] * o1[1]) + (o1[2] * o1[2] + o1[3] * o1[3])); }
                if (WH) { ss += __shfl_xor(ss, 16); ss += __shfl_xor(ss, 32); if (fq == 0) atomicAdd(sumsq + row, ss); } }
            asm volatile("" ::: "memory"); }
    }
};
struct EpiNull {
    static constexpr bool PERM = false, AFTER_DRAIN = false; float* out;
    __device__ __forceinline__ void operator()(const f32x4 (&acc)[2][2][4][2], const Unit& u, int wr, int wc, int fr, int fq) const {
        float s = 0.f;
#pragma unroll
        for (int ai = 0; ai < 2; ++ai)
#pragma unroll
            for (int bj = 0; bj < 2; ++bj)
#pragma unroll
                for (int m = 0; m < 4; ++m)
#pragma unroll
                    for (int n = 0; n < 2; ++n) s += acc[ai][bj][m][n][0] + acc[ai][bj][m][n][1] + acc[ai][bj][m][n][2] + acc[ai][bj][m][n][3];
        if (s != s) out[u.pm * 7 + u.pn + wr + wc + fr + fq] = s;
    }
};
__device__ __forceinline__ float log_sigmoid(float x) { return x < 0.f ? x - log1pf(expf(x)) : -log1pf(expf(-x)); }
__device__ __forceinline__ void heads_store(const f32x4 (&acc)[2][2][4][2], int pm, int wr, int wc, int fr, int fq, PG8_LAS float* xch,
                                            const float* sumsq, float inv_n, float eps, bool nrm0, bool nrm1, const float* gain0, const float* gain1, bf16_t* O0, bf16_t* O1) {
    const int rl0 = wr * 64 + fr, col8 = wc * 32 + 8 * fq;
    float rs[2][4];
#pragma unroll
    for (int ai = 0; ai < 2; ++ai)
#pragma unroll
        for (int m = 0; m < 4; ++m) { const int rl = rl0 + ai * HALF + m * 16;
            rs[ai][m] = sumsq ? 1.0f / sqrtf(sumsq[pm * BM + rl] * inv_n + eps) : 1.f;
#pragma unroll
            for (int bj = 0; bj < 2; ++bj) { const f32x4 v0 = acc[ai][bj][m][0] * rs[ai][m], v1 = acc[ai][bj][m][1] * rs[ai][m];
                float ss = ((v0[0] * v0[0] + v0[1] * v0[1]) + (v0[2] * v0[2] + v0[3] * v0[3])) + ((v1[0] * v1[0] + v1[1] * v1[1]) + (v1[2] * v1[2] + v1[3] * v1[3]));
                ss += __shfl_xor(ss, 16); ss += __shfl_xor(ss, 32);
                if (fq == 0) xch[(rl * 2 + bj) * 4 + wc] = ss; } }
    asm volatile("s_waitcnt lgkmcnt(0)" ::: "memory"); __builtin_amdgcn_s_barrier(); asm volatile("" ::: "memory");
    f32x4 g[2][2];
#pragma unroll
    for (int n = 0; n < 2; ++n) { g[0][n] = nrm0 ? *(const f32x4*)(gain0 + col8 + 4 * n) : (f32x4){1.f, 1.f, 1.f, 1.f}; g[1][n] = nrm1 ? *(const f32x4*)(gain1 + col8 + 4 * n) : (f32x4){1.f, 1.f, 1.f, 1.f}; }
#pragma unroll
    for (int ai = 0; ai < 2; ++ai)
#pragma unroll
        for (int m = 0; m < 4; ++m) { const int rl = rl0 + ai * HALF + m * 16;
#pragma unroll
            for (int bj = 0; bj < 2; ++bj) { float sc = rs[ai][m];
                if (bj == 0 ? nrm0 : nrm1) { const f32x4 pp = *(const PG8_LAS f32x4*)(xch + (rl * 2 + bj) * 4); sc *= 1.0f / sqrtf(((pp[0] + pp[1]) + (pp[2] + pp[3])) * (1.f / 128.f) + eps); }
                const f32x4 s0 = g[bj][0] * sc, s1 = g[bj][1] * sc;
                const f32x4 v0 = acc[ai][bj][m][0] * s0, v1 = acc[ai][bj][m][1] * s1;
                u32x4 w; w.x = cvt_pk_bf16(v0[0], v0[1]); w.y = cvt_pk_bf16(v0[2], v0[3]); w.z = cvt_pk_bf16(v1[0], v1[1]); w.w = cvt_pk_bf16(v1[2], v1[3]);
                *(u32x4*)((bj == 0 ? O0 : O1) + (size_t)(pm * BM + rl) * 128 + col8) = w; } }
}
struct EpiInProj {
    static constexpr bool PERM = true, AFTER_DRAIN = false;
    bf16_t* HB; const float* sumsq; float inv_n, eps; int rows; PG8_LAS float* xch; const float* gt;
    __device__ __forceinline__ int gidx(int hh) const { return hh < 6 ? 0 : hh < 12 ? 1 : hh < 24 ? 2 : hh < 26 ? 3 : 4; }
    __device__ __forceinline__ bool nrm_of(int hh) const { return hh < 12 || (hh >= 18 && hh < 26) || hh >= 28; }
    __device__ __forceinline__ void operator()(const f32x4 (&acc)[2][2][4][2], const Unit& u, int wr, int wc, int fr, int fq) const {
        const int h0 = 2 * u.pn, h1 = h0 + 1;
        heads_store(acc, u.pm, wr, wc, fr, fq, xch, sumsq, inv_n, eps, nrm_of(h0), nrm_of(h1), gt + gidx(h0) * 128, gt + gidx(h1) * 128, HB + (size_t)h0 * rows * 128, HB + (size_t)h1 * rows * 128);
    }
};
struct EpiMemKV {
    static constexpr bool PERM = true, AFTER_DRAIN = false;
    bf16_t* O; int rows; float eps; PG8_LAS float* xch; const float* g_mk;
    __device__ __forceinline__ void operator()(const f32x4 (&acc)[2][2][4][2], const Unit& u, int wr, int wc, int fr, int fq) const {
        const int h0 = 2 * u.pn, h1 = h0 + 1; const bool nk = h0 < 4;
        heads_store(acc, u.pm, wr, wc, fr, fq, xch, nullptr, 0.f, eps, nk, nk, g_mk, g_mk, O + (size_t)h0 * rows * 128, O + (size_t)h1 * rows * 128);
    }
};

template <class Epi, class Sched, bool ALIGN_EPI = false, bool SP2 = false>
__device__ __forceinline__ void gemm_phase(PG8_LAS unsigned char* lds, const Gemm g, const Sched S, const Epi E, int wave_id) {
    const int lane = mk_lane(), wid = wave_id, tid = wid * 64 + lane, wr = wid >> 2, wc = wid & 3, fr = lane & 15, fq = lane >> 4;
    const int K = g.K, nt = K / BK;
    unsigned voffA[2], voffB[2];
#pragma unroll
    for (int i = 0; i < 2; ++i) { int R, C; stage_rc(tid * 16 + i * 8192, R, C); const int Rb = Epi::PERM ? ((R & ~31) + perm32(R & 31)) : R;
        voffA[i] = (unsigned)(R * K + C) * 2u; voffB[i] = (unsigned)(Rb * K + C) * 2u; }
    const size_t kstep = (size_t)(BK * 2);
    const size_t hstep = (size_t)HALF * K * 2;
    const size_t tstep = 2 * hstep;
    const unsigned ldsw = (unsigned)wid * 1024u;
    const int aoff = lds_byte(wr * 64 + fr, fq * 8), boff = lds_byte(wc * 32 + fr, fq * 8);
#define PG8_SA(b, h) (((b) * 2 + (h)) * HTB)
#define PG8_SB(b, h) ((4 + (b) * 2 + (h)) * HTB)
#define PG8_STAGE(bufoff, gbase, voff) do { _Pragma("unroll") for (int _i = 0; _i < 2; ++_i) \
        __builtin_amdgcn_global_load_lds((const unsigned*)((const char*)(gbase) + (voff)[_i]), (PG8_LAS unsigned*)(lds + (bufoff) + ldsw + _i * 8192), 16, 0, 0); } while (0)
#define PG8_LDA(dst, b, h) do { _Pragma("unroll") for (int m = 0; m < 4; ++m) _Pragma("unroll") for (int k = 0; k < 2; ++k) dst[m][k] = *(const PG8_LAS bf16x8*)(lds + PG8_SA(b, h) + aoff + m * 2048 + k * 1024); } while (0)
#define PG8_LDB(dst, b, h) do { _Pragma("unroll") for (int n = 0; n < 2; ++n) _Pragma("unroll") for (int k = 0; k < 2; ++k) dst[n][k] = *(const PG8_LAS bf16x8*)(lds + PG8_SB(b, h) + boff + n * 2048 + k * 1024); } while (0)
#define PG8_MMA(ai, bj, At, Bt) do { __builtin_amdgcn_s_setprio(1); _Pragma("unroll") for (int m = 0; m < 4; ++m) _Pragma("unroll") for (int n = 0; n < 2; ++n) _Pragma("unroll") for (int k = 0; k < 2; ++k) \
        acc[ai][bj][m][n] = __builtin_amdgcn_mfma_f32_16x16x32_bf16(Bt[n][k], At[m][k], acc[ai][bj][m][n], 0, 0, 0); __builtin_amdgcn_s_setprio(0); } while (0)
#define PG8_WAIT_V(n) asm volatile("s_waitcnt vmcnt(" #n ")" ::: "memory")
#define PG8_WAIT_L(n) asm volatile("s_waitcnt lgkmcnt(" #n ")" ::: "memory")
#define PG8_BAR __builtin_amdgcn_s_barrier()
#define PG8_SCHED __builtin_amdgcn_sched_barrier(0)
    Unit cur, nxt; int ui = 0;
    if (!S.next(0, cur)) return;
    f32x4 acc[2][2][4][2];
#pragma unroll
    for (int a = 0; a < 2; ++a)
#pragma unroll
        for (int b = 0; b < 2; ++b)
#pragma unroll
            for (int m = 0; m < 4; ++m)
#pragma unroll
                for (int n = 0; n < 2; ++n) acc[a][b][m][n] = (f32x4){0.f, 0.f, 0.f, 0.f};
    bf16x8 At[4][2], B0[2][2], B1[2][2];
    const char* cA = (const char*)g.A + (size_t)cur.pm * tstep; const char* cB = (const char*)g.Bt + (size_t)cur.pn * tstep;
    S.a_ready(cur);
    if constexpr (SP2) {
        PG8_STAGE(PG8_SB(0, 0), cB, voffB); PG8_STAGE(PG8_SB(0, 1), cB + hstep, voffB); PG8_STAGE(PG8_SA(0, 0), cA, voffA); PG8_STAGE(PG8_SA(0, 1), cA + hstep, voffA);
        if (wr == 1) PG8_BAR;
        PG8_WAIT_V(2); PG8_BAR;
        PG8_STAGE(PG8_SB(1, 0), cB + kstep, voffB); PG8_STAGE(PG8_SA(1, 0), cA + kstep, voffA); PG8_STAGE(PG8_SB(1, 1), cB + hstep + kstep, voffB);
        PG8_WAIT_V(6); PG8_BAR;
    } else {
        PG8_STAGE(PG8_SB(0, 0), cB, voffB); PG8_STAGE(PG8_SA(0, 0), cA, voffA); PG8_STAGE(PG8_SB(0, 1), cB + hstep, voffB); PG8_STAGE(PG8_SA(0, 1), cA + hstep, voffA);
        if (wr == 1) PG8_BAR;
        PG8_WAIT_V(4); PG8_BAR;
        PG8_STAGE(PG8_SB(1, 0), cB + kstep, voffB); PG8_STAGE(PG8_SA(1, 0), cA + kstep, voffA); PG8_STAGE(PG8_SB(1, 1), cB + hstep + kstep, voffB);
        PG8_WAIT_V(6); PG8_BAR;
    }
    for (;;) {
        const bool has_next = S.next(ui + 1, nxt);
        const char* nA = has_next ? (const char*)g.A + (size_t)nxt.pm * tstep : cA; const char* nB = has_next ? (const char*)g.Bt + (size_t)nxt.pn * tstep : cB;
        for (int t = 0; t < nt; t += 2) {
            const bool last = (t == nt - 2);
            const char* a1 = cA + (size_t)(t + 1) * kstep;
            const char* a2 = last ? nA : cA + (size_t)(t + 2) * kstep; const char* b2 = last ? nB : cB + (size_t)(t + 2) * kstep;
            const char* a3 = a2 + kstep; const char* b3 = b2 + kstep;
            if (last && has_next) S.a_ready(nxt);
            if constexpr (SP2) {
            PG8_LDB(B0, 0, 0); PG8_LDB(B1, 0, 1); PG8_SCHED; PG8_LDA(At, 0, 0); PG8_STAGE(PG8_SA(1, 1), a1 + hstep, voffA);
            PG8_WAIT_V(8); PG8_WAIT_L(0); PG8_BAR; PG8_MMA(0, 0, At, B0); PG8_MMA(0, 1, At, B1); PG8_BAR; PG8_SCHED;
            PG8_LDA(At, 0, 1); PG8_STAGE(PG8_SB(0, 0), b2, voffB); PG8_STAGE(PG8_SB(0, 1), b2 + hstep, voffB); PG8_STAGE(PG8_SA(0, 0), a2, voffA);
            PG8_WAIT_V(8); PG8_WAIT_L(0); PG8_BAR; PG8_MMA(1, 0, At, B0); PG8_MMA(1, 1, At, B1); PG8_BAR; PG8_SCHED;
            PG8_LDB(B0, 1, 0); PG8_LDB(B1, 1, 1); PG8_SCHED; PG8_LDA(At, 1, 0); PG8_STAGE(PG8_SA(0, 1), a2 + hstep, voffA);
            PG8_WAIT_V(8); PG8_WAIT_L(0); PG8_BAR; PG8_MMA(0, 0, At, B0); PG8_MMA(0, 1, At, B1); PG8_BAR; PG8_SCHED;
            PG8_LDA(At, 1, 1); PG8_STAGE(PG8_SB(1, 0), b3, voffB); PG8_STAGE(PG8_SB(1, 1), b3 + hstep, voffB); PG8_STAGE(PG8_SA(1, 0), a3, voffA);
            PG8_WAIT_V(8); PG8_WAIT_L(0); PG8_BAR; PG8_MMA(1, 0, At, B0); PG8_MMA(1, 1, At, B1); PG8_BAR; PG8_SCHED;
            } else {
            PG8_LDB(B0, 0, 0); PG8_SCHED; PG8_LDA(At, 0, 0); PG8_STAGE(PG8_SA(1, 1), a1 + hstep, voffA);
            PG8_WAIT_L(8); PG8_BAR; PG8_WAIT_L(0); PG8_MMA(0, 0, At, B0); PG8_BAR; PG8_SCHED;
            PG8_LDB(B1, 0, 1); PG8_STAGE(PG8_SB(0, 0), b2, voffB);
            PG8_BAR; PG8_WAIT_L(0); PG8_MMA(0, 1, At, B1); PG8_BAR;
            PG8_LDA(At, 0, 1); PG8_STAGE(PG8_SA(0, 0), a2, voffA);
            PG8_BAR; PG8_WAIT_L(0); PG8_MMA(1, 0, At, B0); PG8_BAR; PG8_SCHED;
            PG8_STAGE(PG8_SB(0, 1), b2 + hstep, voffB);
            PG8_WAIT_V(6); PG8_BAR; PG8_MMA(1, 1, At, B1); PG8_BAR;
            PG8_LDB(B0, 1, 0); PG8_SCHED; PG8_LDA(At, 1, 0); PG8_STAGE(PG8_SA(0, 1), a2 + hstep, voffA);
            PG8_WAIT_L(8); PG8_BAR; PG8_WAIT_L(0); PG8_MMA(0, 0, At, B0); PG8_BAR; PG8_SCHED;
            PG8_LDB(B1, 1, 1); PG8_STAGE(PG8_SB(1, 0), b3, voffB);
            PG8_BAR; PG8_WAIT_L(0); PG8_MMA(0, 1, At, B1); PG8_BAR;
            PG8_LDA(At, 1, 1); PG8_STAGE(PG8_SA(1, 0), a3, voffA);
            PG8_BAR; PG8_WAIT_L(0); PG8_MMA(1, 0, At, B0); PG8_BAR; PG8_SCHED;
            PG8_STAGE(PG8_SB(1, 1), b3 + hstep, voffB);
            PG8_WAIT_V(6); PG8_BAR; PG8_MMA(1, 1, At, B1); PG8_BAR;
            }
        }
        if constexpr (ALIGN_EPI) { if (wr == 0) PG8_BAR; }
        if constexpr (!Epi::AFTER_DRAIN) { E(acc, cur, wr, wc, fr, fq); S.done(cur); }
        if (!has_next) break;
#pragma unroll
        for (int a = 0; a < 2; ++a)
#pragma unroll
            for (int b = 0; b < 2; ++b)
#pragma unroll
                for (int m = 0; m < 4; ++m)
#pragma unroll
                    for (int n = 0; n < 2; ++n) acc[a][b][m][n] = (f32x4){0.f, 0.f, 0.f, 0.f};
        cur = nxt; cA = nA; cB = nB; ++ui;
        if constexpr (ALIGN_EPI) { if (wr == 1) PG8_BAR; }
    }
    PG8_WAIT_V(0);
    if constexpr (!ALIGN_EPI) { if (wr == 0) PG8_BAR; }
    PG8_BAR;
    if constexpr (Epi::AFTER_DRAIN) { E.fused(acc, cur, wr, wc, fr, fq, lds, wid, lane); S.done(cur); }
#undef PG8_SA
#undef PG8_SB
#undef PG8_STAGE
#undef PG8_LDA
#undef PG8_LDB
#undef PG8_MMA
#undef PG8_WAIT_V
#undef PG8_WAIT_L
#undef PG8_BAR
#undef PG8_SCHED
}
}

namespace att {
#define ATT_LAS __attribute__((address_space(3)))
typedef unsigned short bf16;
typedef short bf16x8 __attribute__((ext_vector_type(8)));
typedef short s16x4 __attribute__((ext_vector_type(4)));
typedef float f32x16 __attribute__((ext_vector_type(16)));
typedef float f32x4 __attribute__((ext_vector_type(4)));
typedef unsigned u32x4 __attribute__((ext_vector_type(4)));
constexpr int D = 128, NW = 8, QBLK = 32, KVBLK = 64, QB = NW * QBLK;
constexpr int SHM_V = KVBLK * D * 2, SHM_K = KVBLK * D * 2;
constexpr int LDS_WS_OFF = 2 * SHM_V + 2 * SHM_K, LDS_CK_OFF = LDS_WS_OFF + NW * 64 * 4, LDS_Q_OFF = LDS_CK_OFF + 4096 * 8, LDS_BYTES = LDS_Q_OFF;
constexpr float SCALE = 0.08838834764831845f, LOG2E = 1.4426950408889634f;
constexpr float THR2 = 64.f;
#ifndef OSTRIDE_T
#define OSTRIDE_T 2048
#endif
constexpr int OSTRIDE = OSTRIDE_T;

#define KSWZ(row, colB) ((row) * 256 + ((colB) ^ (((row) & 7) << 4)))
#define SBAR() __builtin_amdgcn_sched_barrier(0)
__device__ __forceinline__ int v_st(int k, int c) { const int kk = (k & ~0xC) | ((k & 4) << 1) | ((k & 8) >> 1); return ((kk >> 3) * 4 + (c >> 5)) * 512 + ((kk & 7) * 32 + (c & 31)) * 2; }
__device__ __forceinline__ int v_rd_base(int lane) { return ((lane & 3) << 3) | (((lane >> 2) & 3) << 6) | (((lane >> 4) & 1) << 5) | (((lane >> 5) & 1) << 8); }
constexpr int v_rd_off(int d0, int ks, int half) { return d0 * 512 + ks * 4096 + half * 2048; }
__device__ __forceinline__ int crow(int r, int hi) { return (r & 3) + 8 * (r >> 2) + 4 * hi; }
__device__ __forceinline__ unsigned cvtpk(float lo, float hi) { unsigned r; asm volatile("v_cvt_pk_bf16_f32 %0, %1, %2" : "=v"(r) : "v"(lo), "v"(hi)); return r; }
__device__ __forceinline__ bf16x8 load8(const bf16* p) { return *reinterpret_cast<const bf16x8*>(p); }
__device__ __forceinline__ void mask_tile(f32x16& p0, f32x16& p1, int dq, unsigned W) {
    const float NEG = -__builtin_inff();
#pragma unroll
    for (int r = 0; r < 16; ++r) { const int c = (r & 3) + 8 * (r >> 2);
        if ((unsigned)(dq - c) >= W) p0[r] = NEG;
        if ((unsigned)(dq - c - 32) >= W) p1[r] = NEG; }
}
typedef unsigned u32x2b __attribute__((ext_vector_type(2)));
__device__ __forceinline__ u32x2b bias_entry(float v) {
    const unsigned w0 = cvtpk(v, 0.f) & 0xffffu; const float r1 = v - __uint_as_float(w0 << 16);
    const unsigned w1 = cvtpk(r1, 0.f) & 0xffffu; const float r2 = r1 - __uint_as_float(w1 << 16);
    const unsigned w2 = cvtpk(r2, 0.f) & 0xffffu;
    return (u32x2b){w0 | (w1 << 16), w2};
}
__device__ __forceinline__ void partialSM(f32x16& p0, f32x16& p1, float& M, float& alpha, unsigned& md1, unsigned& md2) {
    float pmax = p0[0]; for (int r = 1; r < 16; ++r) pmax = fmaxf(pmax, p0[r]); for (int r = 0; r < 16; ++r) pmax = fmaxf(pmax, p1[r]);
    { auto rr = __builtin_amdgcn_permlane32_swap(__float_as_uint(pmax), __float_as_uint(pmax), false, false);
      pmax = fmaxf(__uint_as_float(rr[0]), __uint_as_float(rr[1])); }
    if (__builtin_expect(__all(pmax <= THR2), 1)) { alpha = 1.f; }
    else { const float dl = fmaxf(pmax, 0.f); M += dl; alpha = __builtin_amdgcn_exp2f(-dl);
        for (int r = 0; r < 16; ++r) { p0[r] -= dl; p1[r] -= dl; }
        const u32x2b e = bias_entry(-M); md1 = 0x3F80u | (e.x << 16); md2 = (e.x >> 16) | (e.y << 16); }
    for (int r = 0; r < 16; ++r) p0[r] = __builtin_amdgcn_exp2f(p0[r]);
}
__device__ __forceinline__ void finishSM(f32x16& p0, f32x16& p1, float alpha, float& l_reg, bf16x8& pa0, bf16x8& pa1, bf16x8& pa2, bf16x8& pa3) {
    for (int r = 0; r < 16; ++r) p1[r] = __builtin_amdgcn_exp2f(p1[r]);
    float ps = 0; for (int r = 0; r < 16; ++r) ps += p0[r]; for (int r = 0; r < 16; ++r) ps += p1[r];
    { auto rr = __builtin_amdgcn_permlane32_swap(__float_as_uint(ps), __float_as_uint(ps), false, false);
      ps = __uint_as_float(rr[0]) + __uint_as_float(rr[1]); }
    l_reg = l_reg * alpha + ps;
#define PK4(P, B_, OUT) do { unsigned a0 = cvtpk(P[B_+0], P[B_+1]), a1 = cvtpk(P[B_+2], P[B_+3]);                          \
        unsigned b0 = cvtpk(P[B_+4], P[B_+5]), b1 = cvtpk(P[B_+6], P[B_+7]);                                             \
        auto r0 = __builtin_amdgcn_permlane32_swap(a0, b0, false, false); auto r1 = __builtin_amdgcn_permlane32_swap(a1, b1, false, false); \
        u32x4 w = {r0[0], r1[0], r0[1], r1[1]}; OUT = *reinterpret_cast<bf16x8*>(&w); } while (0)
    PK4(p0, 0, pa0); PK4(p0, 8, pa1); PK4(p1, 0, pa2); PK4(p1, 8, pa3);
#undef PK4
}
template <int KB>
__device__ __forceinline__ void qkt(f32x16& p0, f32x16& p1, const char* K_lds, int r32, int hi, const bf16x8* qr, const ATT_LAS char* nbp, unsigned md1, unsigned md2) {
    { const u32x2b e0 = *(const ATT_LAS u32x2b*)(nbp), e1 = *(const ATT_LAS u32x2b*)(nbp + 32 * 8);
      const u32x4 a0 = {e0.x, e0.y | 0x3F800000u, 0x3F803F80u, 0u}, a1 = {e1.x, e1.y | 0x3F800000u, 0x3F803F80u, 0u};
      const u32x4 on = {hi ? 0u : 0x3F803F80u, hi ? 0u : md1, hi ? 0u : md2, 0u};
      p0 = __builtin_amdgcn_mfma_f32_32x32x16_bf16(*reinterpret_cast<const bf16x8*>(&a0), *reinterpret_cast<const bf16x8*>(&on), f32x16{}, 0, 0, 0);
      p1 = __builtin_amdgcn_mfma_f32_32x32x16_bf16(*reinterpret_cast<const bf16x8*>(&a1), *reinterpret_cast<const bf16x8*>(&on), f32x16{}, 0, 0, 0); }
    const char* kb[4];
#pragma unroll
    for (int dd = 0; dd < 4; ++dd) kb[dd] = K_lds + KB * SHM_K + KSWZ(r32, (dd * 16 + hi * 8) * 2);
#pragma unroll
    for (int d0 = 0; d0 < 8; ++d0) { const char* a = kb[d0 & 3] + (d0 >> 2) * 128;
        bf16x8 b0 = *reinterpret_cast<const bf16x8*>(a);
        bf16x8 b1 = *reinterpret_cast<const bf16x8*>(a + 32 * 256);
        const bf16x8 q = qr[d0];
        p0 = __builtin_amdgcn_mfma_f32_32x32x16_bf16(b0, q, p0, 0, 0, 0);
        p1 = __builtin_amdgcn_mfma_f32_32x32x16_bf16(b1, q, p1, 0, 0, 0); }
}
template <int VB>
__device__ __forceinline__ void pv_tile(f32x16* o, int vb0, bf16x8 pa0, bf16x8 pa1, bf16x8 pa2, bf16x8 pa3) {
#define TRRD(dst, off) asm volatile("ds_read_b64_tr_b16 %0, %1 offset:%2" : "=&v"(dst) : "v"(vb0), "i"(off) : "memory")
#define PV_D0(d0) do { s16x4 l0, l1, l2, l3, h0, h1, h2, h3; constexpr int b_ = VB * SHM_V + v_rd_off(d0, 0, 0); \
        TRRD(l0, b_); TRRD(h0, b_ + 2048); TRRD(l1, b_ + 4096); TRRD(h1, b_ + 6144); TRRD(l2, b_ + 8192); TRRD(h2, b_ + 10240); TRRD(l3, b_ + 12288); TRRD(h3, b_ + 14336); \
        asm volatile("s_waitcnt lgkmcnt(0)" ::: "memory"); SBAR(); \
        o[d0] = __builtin_amdgcn_mfma_f32_32x32x16_bf16(pa0, (bf16x8){l0[0], l0[1], l0[2], l0[3], h0[0], h0[1], h0[2], h0[3]}, o[d0], 0, 0, 0);   \
        o[d0] = __builtin_amdgcn_mfma_f32_32x32x16_bf16(pa1, (bf16x8){l1[0], l1[1], l1[2], l1[3], h1[0], h1[1], h1[2], h1[3]}, o[d0], 0, 0, 0);   \
        o[d0] = __builtin_amdgcn_mfma_f32_32x32x16_bf16(pa2, (bf16x8){l2[0], l2[1], l2[2], l2[3], h2[0], h2[1], h2[2], h2[3]}, o[d0], 0, 0, 0);   \
        o[d0] = __builtin_amdgcn_mfma_f32_32x32x16_bf16(pa3, (bf16x8){l3[0], l3[1], l3[2], l3[3], h3[0], h3[1], h3[2], h3[3]}, o[d0], 0, 0, 0); } while (0)
    PV_D0(0); PV_D0(1); PV_D0(2); PV_D0(3);
#undef PV_D0
#undef TRRD
}

struct BlockRef { const bf16* Q; const bf16* K; const bf16* V; bf16* O; const float* ck; int P0, W, skv, mode; float sl, sinkl2; };
struct Seam { bf16x8 qr[8]; bf16x8 st_v0, st_v1, st_k0, st_k1; };
__device__ __forceinline__ int swa_jlo(int P0, int W) { const int lowk = P0 - W + 1; return lowk > 0 ? lowk / KVBLK : 0; }
#define ROW(p, k0, rr) ((p) + (size_t)((k0) + (rr)) * D + sc)
#define VMW() asm volatile("s_waitcnt vmcnt(0)" ::: "memory")
#define VMWN(n) asm volatile("s_waitcnt vmcnt(%0)" :: "i"(n) : "memory")
#define SLOAD_H(Kp, Vp, k0) do { S.st_v0 = load8(ROW(Vp, k0, sr)); S.st_v1 = load8(ROW(Vp, k0, 32 + sr));              \
                         S.st_k0 = load8(ROW(Kp, k0, sr)); S.st_k1 = load8(ROW(Kp, k0, 32 + sr)); } while (0)
#define SWRITE_HK(bf) do { *(bf16x8*)(K_lds + (bf) * SHM_K + kws) = S.st_k0; *(bf16x8*)(K_lds + (bf) * SHM_K + kws + 32 * 256) = S.st_k1; } while (0)
#define SWRITE_HV(bf) do { *(bf16x8*)(V_lds + (bf) * SHM_V + vst0) = S.st_v0; *(bf16x8*)(V_lds + (bf) * SHM_V + vst1) = S.st_v1; } while (0)
#define SWRITE_H(bf) do { SWRITE_HV(bf); SWRITE_HK(bf); } while (0)
__device__ __forceinline__ void attn_prime(const BlockRef& cur, char* lds, Seam& S, int wave_id) {
    const int lane = mk_lane(), wid = wave_id, tid = wid * 64 + lane, r32 = lane & 31, hi = lane >> 5;
    const int sr = tid >> 4, sc = (tid & 15) * 8, kws = KSWZ(sr, sc * 2); char* K_lds = lds + 2 * SHM_V;
    const int kb0 = swa_jlo(cur.P0, cur.W) * KVBLK;
    for (int d0 = 0; d0 < 8; ++d0) S.qr[d0] = load8(cur.Q + (size_t)(wid * QBLK + r32) * D + d0 * 16 + hi * 8);
    SLOAD_H(cur.K, cur.V, kb0); VMW(); SWRITE_HK(0);
    __syncthreads();
}
__device__ __forceinline__ void attn_block(const BlockRef& cur, const BlockRef& nxt, char* lds, Seam& S, int wave_id) {
    const int lane = mk_lane(), wid = wave_id, tid = wid * 64 + lane, r32 = lane & 31, hi = lane >> 5;
    const int W = cur.W, mode = cur.mode, skv = cur.skv;
    const int j_lo = swa_jlo(cur.P0, W);
    int j_hi = (cur.P0 + QB - 1) / KVBLK + 1; if (j_hi > skv / KVBLK) j_hi = skv / KVBLK;
    const int NT = j_hi - j_lo;
    const int kbn = swa_jlo(nxt.P0, nxt.W) * KVBLK;
    const int qlo = cur.P0 + wid * QBLK, qm = qlo + r32 - 4 * hi;
    char* V_lds = lds; char* K_lds = lds + 2 * SHM_V;
    float* ws = (float*)(lds + LDS_WS_OFF) + wid * 64; float* li_l = ws, * al_l = ws + 32;
    const ATT_LAS float* ckl = (const ATT_LAS float*)(lds + LDS_CK_OFF);
    {
        ATT_LAS u32x2b* nb = (ATT_LAS u32x2b*)(lds + LDS_CK_OFF); const int nk = NT * KVBLK;
        if (mode == 0) {
            float* wt = (float*)(lds + LDS_WS_OFF); const bool actv = tid * 8 < nk;
            f32x4 a = {0.f, 0.f, 0.f, 0.f}, b = {0.f, 0.f, 0.f, 0.f};
            if (actv) { a = *(const f32x4*)(cur.ck + tid * 8); b = *(const f32x4*)(cur.ck + tid * 8 + 4); }
            a.y += a.x; a.z += a.y; a.w += a.z; b.x += a.w; b.y += b.x; b.z += b.y; b.w += b.z;
            float xs = b.w;
#pragma unroll
            for (int o_ = 1; o_ < 64; o_ <<= 1) { const float y = __shfl_up(xs, o_); if (lane >= o_) xs += y; }
            if (lane == 63) wt[wid] = xs;
            __syncthreads();
            float off = xs - b.w;
            for (int w2 = 0; w2 < wid; ++w2) off += wt[w2];
            a = a + off; b = b + off;
            if (tid * 8 == cur.P0) wt[8] = a.x;
            __syncthreads();
            const float cref = wt[8], k = LOG2E;
            if (actv) { const f32x4 va = (cref - a) * k, vb = (cref - b) * k;
#pragma unroll
                for (int i = 0; i < 4; ++i) { nb[tid * 8 + i] = bias_entry(va[i]); nb[tid * 8 + 4 + i] = bias_entry(vb[i]); } } }
        else { const float sl_ = (mode == 1) ? cur.sl : 0.f;
            for (int i = tid; i < nk; i += 512) nb[i] = bias_entry(sl_ * (float)(j_lo * KVBLK + i - cur.P0)); }
        __syncthreads();
    }
    const ATT_LAS char* nbl = (const ATT_LAS char*)(lds + LDS_CK_OFF) + r32 * 8;
    float m_reg = 0.f, l_reg = 0; unsigned md1 = 0x3F80u, md2 = 0u; f32x16 o[4] = {};
    const int sr = tid >> 4, sc = (tid & 15) * 8, vst0 = v_st(sr, sc), vst1 = v_st(32 + sr, sc), kws = KSWZ(sr, sc * 2);
    const int vb0 = (int)(uintptr_t)V_lds + v_rd_base(lane);
    const bf16* Kh = cur.K; const bf16* Vh = cur.V;
#define RESC(a) do { if (__any((a) < 1.f)) { if (hi == 0) al_l[r32] = (a); asm volatile("s_waitcnt lgkmcnt(0)" ::: "memory");              \
                     for (int d_ = 0; d_ < 4; ++d_) for (int r = 0; r < 16; ++r) o[d_][r] *= al_l[crow(r, hi)]; } } while (0)
#define KBASE(t) ((j_lo + (t)) * KVBLK)
#define MASKT(P0_, P1_, t) do { const int kb_ = KBASE(t); \
        if (kb_ + KVBLK - 1 > qlo || kb_ <= qlo + QBLK - 1 - W) mask_tile(P0_, P1_, qm - kb_, (unsigned)W); } while (0)
    constexpr int NQL = 8;
#define SEAM_K0() do { VMWN(NQL); SWRITE_HK(0); SBAR(); } while (0)
    f32x16 pA0, pA1, pB0, pB1; float alA, alB; bf16x8 pa0, pa1, pa2, pa3;
    SWRITE_HV(0); SBAR();
    if (NT > 1) { SLOAD_H(Kh, Vh, KBASE(1)); }
    SBAR(); qkt<0>(pA0, pA1, K_lds, r32, hi, S.qr, nbl, md1, md2);
    MASKT(pA0, pA1, 0); partialSM(pA0, pA1, m_reg, alA, md1, md2);
    if (NT > 1) { VMW(); SWRITE_H(1); }
    __syncthreads();
#define HALF_STEP(PX0, PX1, alX, PY0, PY1, alY, t, KB, VB, SB) do {                                                      \
        SBAR(); if ((t) + 1 < NT) { SLOAD_H(Kh, Vh, KBASE((t) + 1)); SBAR(); }     \
        qkt<KB>(PX0, PX1, K_lds, r32, hi, S.qr, nbl + (t) * (KVBLK * 8), md1, md2);                                                                    \
        finishSM(PY0, PY1, alY, l_reg, pa0, pa1, pa2, pa3); SBAR();                                                           \
        pv_tile<VB>(o, vb0, pa0, pa1, pa2, pa3); MASKT(PX0, PX1, (t)); partialSM(PX0, PX1, m_reg, alX, md1, md2);                  \
        __syncthreads();                                                                                                      \
        if ((t) + 1 < NT) { VMW(); SWRITE_H(SB); }                                                                            \
        RESC(alX); __syncthreads(); } while (0)
    for (int t = 1; t + 1 < NT; t += 2) {
        HALF_STEP(pB0, pB1, alB, pA0, pA1, alA, t, 1, 0, 0);
        HALF_STEP(pA0, pA1, alA, pB0, pB1, alB, t + 1, 0, 1, 1);
    }
    const bool even = (NT & 1) == 0;
    if (even) { SBAR(); qkt<1>(pB0, pB1, K_lds, r32, hi, S.qr, nbl + (NT - 1) * (KVBLK * 8), md1, md2); SBAR(); }
    SLOAD_H(nxt.K, nxt.V, kbn); SBAR();
#pragma unroll
    for (int d0 = 0; d0 < 8; ++d0) S.qr[d0] = load8(nxt.Q + (size_t)(wid * QBLK + r32) * D + d0 * 16 + hi * 8);
    SBAR();
    finishSM(pA0, pA1, alA, l_reg, pa0, pa1, pa2, pa3); SBAR();
    pv_tile<0>(o, vb0, pa0, pa1, pa2, pa3);
    if (even) { MASKT(pB0, pB1, NT - 1); partialSM(pB0, pB1, m_reg, alB, md1, md2); __syncthreads(); RESC(alB);
        finishSM(pB0, pB1, alB, l_reg, pa0, pa1, pa2, pa3); SBAR(); pv_tile<1>(o, vb0, pa0, pa1, pa2, pa3); }
    SBAR(); SEAM_K0();
    { float lfin = l_reg;
#ifndef TEST_NOSINK
 if (mode == 1) lfin += __builtin_amdgcn_exp2f(cur.sinkl2 + cur.sl * (float)(qlo + r32 - cur.P0) - m_reg);
#endif

      if (hi == 0) li_l[r32] = lfin; }
    asm volatile("s_waitcnt lgkmcnt(0)" ::: "memory");
    float rli[16];
#pragma unroll
    for (int r = 0; r < 16; ++r) rli[r] = __builtin_amdgcn_rcpf(li_l[crow(r, hi)]);
    bf16* Ow = cur.O + (size_t)(wid * QBLK) * OSTRIDE;
#pragma unroll
    for (int r = 0; r < 16; ++r) { const int orow = crow(r, hi);
#pragma unroll
        for (int d0 = 0; d0 < 4; ++d0) { const float v = o[d0][r] * rli[r];
            const float vn = __shfl_xor(v, 1);
            if ((r32 & 1) == 0) *(unsigned*)(Ow + (size_t)orow * OSTRIDE + d0 * 32 + r32) = cvtpk(v, vn); } }
    __syncthreads();
#undef RESC
#undef KBASE
#undef MASKT
#undef SEAM_K0
#undef HALF_STEP
}
#undef ROW
#undef VMW
#undef VMWN
#undef SLOAD_H
#undef SWRITE_HK
#undef SWRITE_HV
#undef SWRITE_H
#undef SBAR
#undef KSWZ
}


#define LAS __attribute__((address_space(3)))
typedef unsigned short bf16;
typedef unsigned v4u __attribute__((ext_vector_type(4)));
typedef float f32x4 __attribute__((ext_vector_type(4)));
constexpr int NBATCH = 4, SEQ = 4096, DM = 2048, T = NBATCH * SEQ, DFF = 5632, HD = 128, MEMLEN = 256, MROWS = NBATCH * MEMLEN;
constexpr int INW = 4102, NIN = 4096, NUP = 2 * DFF;
constexpr float EPS = 1e-6f;
constexpr size_t MiB = 1u << 20;
constexpr size_t WS_BAR = 1 * MiB, BAR_BYTES = 16384; constexpr int MEMFLAG = 3520;
constexpr size_t WS_SS1 = 0, WS_SS2 = 64 * 1024, WS_LOGF = 128 * 1024, WS_CUM = 512 * 1024, WS_GT = 960 * 1024;
constexpr size_t WS_BT_UP1 = 2 * MiB, WS_BT_DN1 = WS_BT_UP1 + 44 * MiB, WS_BT_UP2 = WS_BT_DN1 + 22 * MiB, WS_BT_DN2 = WS_BT_UP2 + 44 * MiB;
constexpr size_t WS_BT_IN = WS_BT_DN2 + 22 * MiB, WS_BT_OUT = WS_BT_IN + 17 * MiB, WS_BT_MEM = WS_BT_OUT + 8 * MiB;
constexpr size_t WS_MN = WS_BT_MEM + 4 * MiB, WS_MKV = WS_MN + 4 * MiB;
constexpr size_t WS_A = WS_MKV + 2 * MiB;
constexpr size_t WS_B = WS_A + 176 * MiB;
constexpr size_t WS_C = WS_B + 64 * MiB;
constexpr size_t WS_END = WS_C + 64 * MiB;
static_assert(WS_END <= 512 * MiB, "d_ws map");
constexpr int LDS_BYTES = 155648;
static_assert(att::LDS_BYTES <= LDS_BYTES, "attention scratch inside the LDS allocation");

__device__ __forceinline__ unsigned f2bf(float f) { unsigned u = __builtin_bit_cast(unsigned, f); return (u + 0x7fffu + ((u >> 16) & 1u)) >> 16; }
__device__ __forceinline__ unsigned pk2(float lo, float hi) { return f2bf(lo) | (f2bf(hi) << 16); }
__device__ __forceinline__ float bflo(unsigned w) { return __uint_as_float(w << 16); }
__device__ __forceinline__ float bfhi(unsigned w) { return __uint_as_float(w & 0xffff0000u); }
__device__ __forceinline__ float wave_sum(float v) {
#pragma unroll
    for (int o = 1; o < 64; o <<= 1) v += __shfl_xor(v, o);
    return v;
}
#define LDS_WAIT() asm volatile("s_waitcnt lgkmcnt(0)" ::: "memory")

__device__ __forceinline__ void tr_item(const float* __restrict__ W, int ldw, int k0, int n0, int nvalid, bf16* WT, int K, int r0, LAS float* scr, int lane) {
    const int c = lane & 31;
    float v[32];
    const float* src = W + (size_t)(k0 + (lane >> 5)) * ldw + n0 + c;
#pragma unroll
    for (int i = 0; i < 32; ++i) { v[i] = 0.f; if (c < nvalid) v[i] = src[(size_t)(2 * i) * ldw]; }
#pragma unroll
    for (int i = 0; i < 32; ++i) scr[(2 * i + (lane >> 5)) * 33 + c] = v[i];
    LDS_WAIT(); asm volatile("" ::: "memory");
    const int c8 = lane & 7;
#pragma unroll
    for (int j = 0; j < 4; ++j) { const int n = (lane >> 3) + 8 * j; const LAS float* s = scr + (8 * c8) * 33 + n;
        v4u o; o.x = pk2(s[0 * 33], s[1 * 33]); o.y = pk2(s[2 * 33], s[3 * 33]); o.z = pk2(s[4 * 33], s[5 * 33]); o.w = pk2(s[6 * 33], s[7 * 33]);
        *(v4u*)(WT + (size_t)(r0 + n) * K + k0 + 8 * c8) = o; }
    LDS_WAIT(); asm volatile("" ::: "memory");
}
__device__ __forceinline__ void tr_matrix_item(const float* W, int ldw, int K, bf16* WT, int nblk, int kind, int item, LAS float* scr, int lane) {
    const int kb = item / nblk, blk = item % nblk; int n0 = 32 * blk, r0 = 32 * blk, nvalid = 32;
    if (kind == 1) r0 = 256 * (blk >> 2) + 32 * (blk & 3);
    else if (kind == 2) r0 = 256 * (blk >> 2) + 32 * (blk & 3) + 128;
    else if (kind == 3) { if (blk < 128) { const int hh = blk >> 2; n0 = (hh < 18 ? hh * 128 : 2310 + (hh - 18) * 128) + 32 * (blk & 3); }
                          else { n0 = 2304; nvalid = 6; } }
    else if (kind == 4) r0 = 512 + 32 * blk;
    tr_item(W, ldw, 64 * kb, n0, nvalid, WT, K, r0, scr, lane);
}

struct TrItem { const float* src; size_t step; bf16* dst; int K; bool ok; const float* gk; };
__device__ __forceinline__ TrItem tr_decode(const float* W, int ldw, int K, bf16* WT, int nblk, int kind, int item, int lane, const float* gain = nullptr) {
    const int kb = item / nblk, blk = item % nblk; int n0 = 32 * blk, r0 = 32 * blk, nvalid = 32;
    if (kind == 1) r0 = 256 * (blk >> 2) + 32 * (blk & 3);
    else if (kind == 2) r0 = 256 * (blk >> 2) + 32 * (blk & 3) + 128;
    else if (kind == 3) { if (blk < 128) { const int hh = blk >> 2; n0 = (hh < 18 ? hh * 128 : 2310 + (hh - 18) * 128) + 32 * (blk & 3); } else { n0 = 2304; nvalid = 6; } }
    else if (kind == 4) r0 = 512 + 32 * blk;
    const int c = lane & 31; TrItem t;
    t.src = W + (size_t)(64 * kb + (lane >> 5)) * ldw + n0 + c; t.step = (size_t)2 * ldw; t.dst = WT + (size_t)r0 * K + 64 * kb; t.K = K; t.ok = c < nvalid; t.gk = gain ? gain + 64 * kb : nullptr;
    return t;
}
__device__ __forceinline__ void tr_load(const TrItem& t, float (&v)[32]) {
#pragma unroll
    for (int i = 0; i < 32; ++i) { v[i] = 0.f; if (t.ok) v[i] = t.src[(size_t)i * t.step]; }
}
__device__ __forceinline__ void tr_store(const TrItem& t, const float (&v)[32], LAS float* scr, int lane) {
    const int c = lane & 31;
#pragma unroll
    for (int i = 0; i < 32; ++i) scr[(2 * i + (lane >> 5)) * 33 + c] = v[i];
    LDS_WAIT(); asm volatile("" ::: "memory");
    const int c8 = lane & 7;
    f32x4 g0 = {1.f, 1.f, 1.f, 1.f}, g1 = g0; if (t.gk) { g0 = *(const f32x4*)(t.gk + 8 * c8); g1 = *(const f32x4*)(t.gk + 8 * c8 + 4); }
#pragma unroll
    for (int j = 0; j < 4; ++j) { const int n = (lane >> 3) + 8 * j; const LAS float* s = scr + (8 * c8) * 33 + n;
        v4u o; o.x = pk2(s[0 * 33] * g0.x, s[1 * 33] * g0.y); o.y = pk2(s[2 * 33] * g0.z, s[3 * 33] * g0.w); o.z = pk2(s[4 * 33] * g1.x, s[5 * 33] * g1.y); o.w = pk2(s[6 * 33] * g1.z, s[7 * 33] * g1.w);
        *(v4u*)(t.dst + (size_t)n * t.K + 8 * c8) = o; }
    LDS_WAIT(); asm volatile("" ::: "memory");
}
__device__ __forceinline__ void rms_row(const float* xrow, const float* g, bf16* orow, int lane) {
    const f32x4* xr = (const f32x4*)xrow + lane; f32x4 v[8]; float s = 0.f;
#pragma unroll
    for (int j = 0; j < 8; ++j) { v[j] = xr[64 * j]; s += (v[j].x * v[j].x + v[j].y * v[j].y) + (v[j].z * v[j].z + v[j].w * v[j].w); }
    const float rstd = 1.0f / sqrtf(wave_sum(s) * (1.f / DM) + EPS);
    unsigned long long* o8 = (unsigned long long*)orow + lane; const f32x4* gr = (const f32x4*)g + lane;
#pragma unroll
    for (int j = 0; j < 8; ++j) { const f32x4 gv = gr[64 * j]; const f32x4 o = v[j] * rstd * gv;
        o8[64 * j] = (unsigned long long)pk2(o.x, o.y) | ((unsigned long long)pk2(o.z, o.w) << 32); }
}


#define XB_TMO      128
#define XB_XCNT(j)  (256  + 64 * (j))
#define XB_XSUB(j)  (1280 + 64 * (j))
#define XB_XGEN(j)  (2304 + 64 * (j))
#define XB_TOP      3328
#define XB_TOPGEN   3392
#define XCD_BAR_WORDS 3456
#define XB_SPIN_CAP (1u << 18)
__device__ __forceinline__ unsigned xb_ld(unsigned* p)              { return __hip_atomic_load(p, __ATOMIC_RELAXED, __HIP_MEMORY_SCOPE_AGENT); }
__device__ __forceinline__ unsigned xb_add(unsigned* p, unsigned v) { return __hip_atomic_fetch_add(p, v, __ATOMIC_RELAXED, __HIP_MEMORY_SCOPE_AGENT); }
__device__ __forceinline__ unsigned xb_xcc_id() { return (unsigned)__builtin_amdgcn_s_getreg((3 << 11) | 20) & 0xFu; }
#define XB_SPIN(cond, bar) do { unsigned _sp = 0; while (cond) { __builtin_amdgcn_s_sleep(1); \
    if ((++_sp & 255u) == 0u) { if (xb_ld(&(bar)[XB_TMO])) break; if (_sp > XB_SPIN_CAP) { atomicAdd(&(bar)[XB_TMO], 1u); break; } } } } while (0)
__device__ __forceinline__ void xcd_barrier_complete(unsigned* bar, unsigned x, unsigned& nloc, unsigned& nx) {
    const unsigned G = gridDim.x * gridDim.y * gridDim.z;
    unsigned sum, cnt, mine, sp = 0u;
    for (;;) {
        sum = 0u; cnt = 0u; mine = 0u;
#pragma unroll
        for (unsigned j = 0; j < 16; ++j) { const unsigned c = xb_ld(&bar[XB_XCNT(j)]); sum += c; cnt += (c > 0u) ? 1u : 0u; mine = (j == x) ? c : mine; }
        if (sum == G) break;
        __builtin_amdgcn_s_sleep(1);
        if ((++sp & 255u) == 0u) { if (xb_ld(&bar[XB_TMO])) break; if (sp > XB_SPIN_CAP) { atomicAdd(&bar[XB_TMO], 1u); break; } }
    }
    nloc = mine > 0u ? mine : 1u; nx = cnt > 0u ? cnt : 1u;
}
__device__ __forceinline__ void xcd_barrier(unsigned* bar, volatile LAS unsigned* st, int wave) {
    asm volatile("s_waitcnt vmcnt(0)" ::: "memory");
    __syncthreads();
    if (wave == 0 && mk_lane() == 0) {
        const unsigned x = xb_xcc_id();
        __builtin_amdgcn_s_waitcnt(0);
        unsigned nloc = st[0], nx = st[1];
        if (nloc == 0u) { xcd_barrier_complete(bar, x, nloc, nx); st[0] = nloc; st[1] = nx; }
        const unsigned old = xb_add(&bar[XB_XSUB(x)], 1u);
        const unsigned gen = old / nloc;
        if (old + 1u == (gen + 1u) * nloc) {
            __builtin_amdgcn_fence(__ATOMIC_RELEASE, "agent");
            asm volatile("s_waitcnt vmcnt(0)" ::: "memory");
            const unsigned og = xb_add(&bar[XB_TOP], 1u);
            const unsigned tg = og / nx;
            if (og + 1u == (tg + 1u) * nx) xb_add(&bar[XB_TOPGEN], 1u);
            else XB_SPIN(xb_ld(&bar[XB_TOPGEN]) == tg, bar);
            __builtin_amdgcn_fence(__ATOMIC_ACQUIRE, "agent");
            xb_add(&bar[XB_XGEN(x)], 1u);
            asm volatile("s_waitcnt vmcnt(0)" ::: "memory");
        } else {
            XB_SPIN(xb_ld(&bar[XB_XGEN(x)]) == gen, bar);
            __builtin_amdgcn_fence(__ATOMIC_ACQUIRE, "agent");
            asm volatile("s_waitcnt vmcnt(0)" ::: "memory");
        }
    }
    __syncthreads();
}

__device__ __forceinline__ void cvt_row(const float* xrow, bf16* orow, float* ss_out, int lane) {
    const f32x4* xr = (const f32x4*)xrow + lane; f32x4 v[8]; float s = 0.f;
#pragma unroll
    for (int j = 0; j < 8; ++j) { v[j] = xr[64 * j]; s += (v[j].x * v[j].x + v[j].y * v[j].y) + (v[j].z * v[j].z + v[j].w * v[j].w); }
    s = wave_sum(s); if (lane == 0) *ss_out = s;
    unsigned long long* o8 = (unsigned long long*)orow + lane;
#pragma unroll
    for (int j = 0; j < 8; ++j) o8[64 * j] = (unsigned long long)pk2(v[j].x, v[j].y) | ((unsigned long long)pk2(v[j].z, v[j].w) << 32);
}

struct Params { const float* in[24]; float* out; unsigned char* ws; };
enum { I_X = 0, I_MEM, I_F1N, I_F1G, I_F1U, I_F1D, I_MIXN, I_MEMN, I_WIN, I_FB, I_WMK, I_WMV, I_FQG, I_FKG, I_SQG, I_SKG, I_SINK, I_MQG, I_MKG, I_WOUT, I_F2N, I_F2G, I_F2U, I_F2D };


__device__ __forceinline__ void get_block(int v, int i, att::BlockRef& r, const bf16* HB, const bf16* MKV, bf16* MIX, const float* CUM, const float* sinks) {
    r.ck = CUM; r.sl = 0.f; r.sinkl2 = 0.f;
    if (v < 192 && i < 2) { const int bh = v >> 3, x = v & 7, qb = (i == 0) ? x : 15 - x, b = bh / 6, h = bh % 6; const size_t row0 = (size_t)b * SEQ;
        r.Q = HB + ((size_t)h * T + row0 + qb * 256) * HD; r.K = HB + ((size_t)(6 + h) * T + row0) * HD; r.V = HB + ((size_t)(12 + h) * T + row0) * HD;
        r.O = MIX + (row0 + qb * 256) * DM + h * HD; r.P0 = qb * 256; r.W = 1 << 20; r.skv = SEQ; r.mode = 0; r.ck = CUM + (size_t)bh * SEQ; }
    else { const int u = v - 192; int s0, ns, m0;
        if (v < 192) { s0 = 0; ns = 0; m0 = 160 + v - 2; }
        else if (u < 16) { s0 = 4 * u; ns = 4; m0 = 4 * u; }
        else if (u < 48) { s0 = 64 + 7 * (u - 16); ns = 7; m0 = 64 + (u - 16); }
        else { s0 = 288 + 6 * (u - 48); ns = 6; m0 = 96 + 4 * (u - 48); }
        if (i < ns) { const int sb = s0 + i, bhs = sb >> 4, qb = sb & 15, b = bhs / 6, h = bhs % 6, kvh = h / 3; const size_t row0 = (size_t)b * SEQ;
            r.Q = HB + ((size_t)(18 + h) * T + row0 + qb * 256) * HD; r.K = HB + ((size_t)(24 + kvh) * T + row0) * HD; r.V = HB + ((size_t)(26 + kvh) * T + row0) * HD;
            r.O = MIX + (row0 + qb * 256) * DM + (6 + h) * HD; r.P0 = qb * 256; r.W = 128; r.skv = SEQ; r.mode = 1;
            r.sl = exp2f(-8.0f * (float)(h + 1) / 6.0f) * att::LOG2E; r.sinkl2 = sinks[h] * att::LOG2E; }
        else { const int mb = m0 + (i - ns), bhm = mb >> 4, qb = mb & 15, b = bhm >> 2, h = bhm & 3; const size_t row0 = (size_t)b * SEQ;
            r.Q = HB + ((size_t)(28 + h) * T + row0 + qb * 256) * HD; r.K = MKV + ((size_t)h * MROWS + b * MEMLEN) * HD; r.V = MKV + ((size_t)(4 + h) * MROWS + b * MEMLEN) * HD;
            r.O = MIX + (row0 + qb * 256) * DM + (12 + h) * HD; r.P0 = 256; r.W = 1 << 20; r.skv = MEMLEN; r.mode = 2; } }
}

#define PHASE_PTRS unsigned char* ws = p.ws; asm volatile("" : "+s"(ws)); \
    float* SS1 = (float*)(ws + WS_SS1); float* SS2 = (float*)(ws + WS_SS2); float* LOGF = (float*)(ws + WS_LOGF); float* CUM = (float*)(ws + WS_CUM); \
    bf16* BT_UP1 = (bf16*)(ws + WS_BT_UP1); bf16* BT_DN1 = (bf16*)(ws + WS_BT_DN1); bf16* BT_UP2 = (bf16*)(ws + WS_BT_UP2); bf16* BT_DN2 = (bf16*)(ws + WS_BT_DN2); \
    bf16* BT_IN = (bf16*)(ws + WS_BT_IN); bf16* BT_OUT = (bf16*)(ws + WS_BT_OUT); bf16* BT_MEM = (bf16*)(ws + WS_BT_MEM); \
    bf16* MN = (bf16*)(ws + WS_MN); bf16* MKV = (bf16*)(ws + WS_MKV); \
    bf16* ACT = (bf16*)(ws + WS_A); bf16* HB = (bf16*)(ws + WS_A); bf16* HBUF = (bf16*)(ws + WS_B); bf16* MIX = (bf16*)(ws + WS_B); bf16* H2 = (bf16*)(ws + WS_C); bf16* X1B = (bf16*)(ws + WS_C); bf16* X2B = (bf16*)(ws + WS_BT_UP1);    \
    const float* x = p.in[I_X]; float* out = p.out; \
    (void)SS1; (void)SS2; (void)LOGF; (void)CUM; (void)BT_UP1; (void)BT_DN1; (void)BT_UP2; (void)BT_DN2; (void)BT_IN; (void)BT_OUT; (void)BT_MEM; (void)MN; (void)MKV; (void)ACT; (void)HB; (void)HBUF; (void)MIX; (void)H2; (void)X1B; (void)X2B; (void)x; (void)out; unsigned* BAR = (unsigned*)(ws + WS_BAR); (void)BAR;
#ifndef REP_P0
#define REP_P0 1
#endif
#ifndef REP_S1
#define REP_S1 1
#endif
#ifndef REP_S4
#define REP_S4 1
#endif
#ifndef REP_S3
#define REP_S3 1
#endif
#ifndef REP_LOGITS
#define REP_LOGITS 1
#endif
#ifndef REP_SYNC
#define REP_SYNC 0
#endif
__global__ void __launch_bounds__(512, 2) fwd_megakernel(Params p) {
    extern __shared__ __attribute__((aligned(16))) unsigned char lds_raw[];
    cg::grid_group grid = cg::this_grid();
    LAS unsigned char* lds = (LAS unsigned char*)lds_raw;
    const int wave = __builtin_amdgcn_readfirstlane((int)threadIdx.x >> 6);
    const int G = gridDim.x, bx = blockIdx.x;
    volatile LAS unsigned* BST = (volatile LAS unsigned*)(lds + LDS_BYTES - 16);
    { unsigned char* ws = p.ws; asm volatile("" : "+s"(ws)); unsigned* BAR = (unsigned*)(ws + WS_BAR);
    if (wave == 0 && mk_lane() == 0) { BST[0] = 0u; BST[1] = 0u; (void)xb_add(&BAR[XB_XCNT(xb_xcc_id())], 1u); } }
#define GRID_BAR() do { unsigned char* wsb_ = p.ws; asm volatile("" : "+s"(wsb_)); xcd_barrier((unsigned*)(wsb_ + WS_BAR), BST, wave); } while (0)

#ifndef ONLY_S4
    for (int rep_ = 0; rep_ < REP_P0; ++rep_)
    {   PHASE_PTRS
        const int lane = mk_lane(), tid = wave * 64 + lane;
        for (int i = bx * 512 + tid; i < 2 * T; i += G * 512) SS1[i] = 0.f;
        if (bx == 0 && tid < 128) { float* GT = (float*)(ws + WS_GT);
            const float qs = att::SCALE * att::LOG2E;
            GT[tid] = p.in[I_FQG][tid] * qs; GT[128 + tid] = p.in[I_FKG][tid]; GT[256 + tid] = p.in[I_SQG][tid] * qs; GT[384 + tid] = p.in[I_SKG][tid]; GT[512 + tid] = p.in[I_MQG][tid] * qs; }
        LAS float* scr = (LAS float*)(lds + wave * 16384);
        const int gw = bx * 8 + wave, NGW = G * 8;
        constexpr int NB_UP = DFF / 32, NB_DM = DM / 32, NB_IN = NIN / 32 + 1, NB_MEM = 512 / 32;
        constexpr int I_GU = (DM / 64) * NB_UP, I_DN = (DFF / 64) * NB_DM, I_IN = (DM / 64) * NB_IN, I_OUT = (DM / 64) * NB_DM, I_MM = (DM / 64) * NB_MEM;
        constexpr int NITEMS = 4 * I_GU + 2 * I_DN + I_IN + I_OUT + 2 * I_MM;
#define P0_DECODE(it_) ([&]() -> TrItem { int r = (it_); \
            if (r < I_GU) return tr_decode(p.in[I_F1G], DFF, DM, BT_UP1, NB_UP, 1, r, lane); r -= I_GU; \
            if (r < I_GU) return tr_decode(p.in[I_F1U], DFF, DM, BT_UP1, NB_UP, 2, r, lane); r -= I_GU; \
            if (r < I_DN) return tr_decode(p.in[I_F1D], DM, DFF, BT_DN1, NB_DM, 0, r, lane); r -= I_DN; \
            if (r < I_IN) return tr_decode(p.in[I_WIN], INW, DM, BT_IN, NB_IN, 3, r, lane, p.in[I_MIXN]); r -= I_IN; \
            if (r < I_MM) return tr_decode(p.in[I_WMK], 512, DM, BT_MEM, NB_MEM, 0, r, lane); r -= I_MM; \
            if (r < I_MM) return tr_decode(p.in[I_WMV], 512, DM, BT_MEM, NB_MEM, 4, r, lane); r -= I_MM; \
            if (r < I_OUT) return tr_decode(p.in[I_WOUT], DM, DM, BT_OUT, NB_DM, 0, r, lane); r -= I_OUT; \
            if (r < I_GU) return tr_decode(p.in[I_F2G], DFF, DM, BT_UP2, NB_UP, 1, r, lane, p.in[I_F2N]); r -= I_GU; \
            if (r < I_GU) return tr_decode(p.in[I_F2U], DFF, DM, BT_UP2, NB_UP, 2, r, lane, p.in[I_F2N]); r -= I_GU; \
            return tr_decode(p.in[I_F2D], DM, DFF, BT_DN2, NB_DM, 0, r, lane); })()
        if (gw < NITEMS) {
            TrItem cur = P0_DECODE(gw); float va[32], vb[32]; tr_load(cur, va);
            for (int it = gw; it < NITEMS; it += 2 * NGW) {
                const int i1 = it + NGW, i2 = it + 2 * NGW; TrItem n1 = cur, n2 = cur;
                if (i1 < NITEMS) { n1 = P0_DECODE(i1); tr_load(n1, vb); }
                tr_store(cur, va, scr, lane);
                if (i1 < NITEMS) { if (i2 < NITEMS) { n2 = P0_DECODE(i2); tr_load(n2, va); } tr_store(n1, vb, scr, lane); cur = n2; }
            }
        }
#undef P0_DECODE
        for (int m = gw; m < T + MROWS; m += NGW) {
            if (m < T) rms_row(x + (size_t)m * DM, p.in[I_F1N], HBUF + (size_t)m * DM, lane);
            else rms_row(p.in[I_MEM] + (size_t)(m - T) * DM, p.in[I_MEMN], MN + (size_t)(m - T) * DM, lane);
        }
    }
    GRID_BAR();
    if (p.ws == nullptr) grid.sync();

    for (int rep_ = 0; rep_ < REP_S1; ++rep_)
    {   PHASE_PTRS
        pg8::Gemm g{HBUF, BT_UP1, T, NUP, DM}; pg8::StaticOrder S; S.init(T, NUP, G, bx);
        pg8::EpiSwiglu E{ACT, DFF, nullptr, 1.f / DM, EPS};
        pg8::gemm_phase<pg8::EpiSwiglu, pg8::StaticOrder, true, true>(lds, g, S, E, wave);
    }
    GRID_BAR();

    {   PHASE_PTRS
        pg8::Gemm g{ACT, BT_DN1, T, DM, DFF}; pg8::StaticOrder S; S.init(T, DM, G, bx);
        pg8::EpiResid<true, false, true, true> E{x, nullptr, nullptr, X1B, SS1};
        pg8::gemm_phase<pg8::EpiResid<true, false, true, true>, pg8::StaticOrder, true, true>(lds, g, S, E, wave);
    }
    GRID_BAR();

    for (int rep_ = 0; rep_ < REP_S3; ++rep_)
    {   PHASE_PTRS
#ifndef TEST_NOLOGITS
        for (int repl_ = 0; repl_ < REP_LOGITS; ++repl_)
        {
            typedef short bf16x8 __attribute__((ext_vector_type(8)));
            const int lane = mk_lane(); LAS f32x4* red = (LAS f32x4*)lds;
            for (int rb = bx * 4 + (wave & 3); rb < T / 16; rb += G * 4) {
                const int kh = wave >> 2;
                const bf16* ap = X1B + (size_t)(rb * 16 + (lane & 15)) * DM + kh * 1024 + (lane >> 4) * 8;
                const bf16* bp = BT_IN + (size_t)(4096 + (lane & 15)) * DM + kh * 1024 + (lane >> 4) * 8;
                f32x4 acc = {0.f, 0.f, 0.f, 0.f};
#pragma unroll 16
                for (int ks = 0; ks < 32; ++ks) { const bf16x8 av = *(const bf16x8*)(ap + ks * 32), bv = *(const bf16x8*)(bp + ks * 32);
                    acc = __builtin_amdgcn_mfma_f32_16x16x32_bf16(av, bv, acc, 0, 0, 0); }
                if (kh == 1) red[(wave & 3) * 64 + lane] = acc;
                __syncthreads();
                if (kh == 0) { acc += red[(wave & 3) * 64 + lane]; const int h = lane & 15;
                    if (h < 6) { const float fb = p.in[I_FB][h];
#pragma unroll
                        for (int r = 0; r < 4; ++r) { const int row = rb * 16 + 4 * (lane >> 4) + r; const float rs = 1.0f / sqrtf(SS1[row] * (1.f / DM) + EPS);
                            LOGF[(size_t)((row >> 12) * 6 + h) * SEQ + (row & 4095)] = pg8::log_sigmoid(acc[r] * rs + fb); } } }
                __syncthreads();
            }
        }
#endif
#ifdef PROBE_S3FULL
        {   pg8::Gemm g0{X1B, BT_IN, T, NIN, DM}; pg8::StaticOrder S0; S0.init(T, NIN, G, bx);
            pg8::EpiInProj E0{(bf16*)out, SS1, 1.f / DM, EPS, T, (LAS float*)(lds + 131072), (const float*)(ws + WS_GT)};
            pg8::gemm_phase<pg8::EpiInProj, pg8::StaticOrder, true, true>(lds, g0, S0, E0, wave); }
#endif
#ifdef PROBE_S3NULL
        {   pg8::Gemm g0{X1B, BT_IN, T, NIN, DM}; pg8::StaticOrder S0; S0.init(T, NIN, G, bx);
            pg8::EpiNull E0{(float*)(ws + WS_B)};
            pg8::gemm_phase<pg8::EpiNull, pg8::StaticOrder, true, true>(lds, g0, S0, E0, wave); }
#endif
        pg8::Gemm g{X1B, BT_IN, T, NIN, DM}; pg8::StaticOrder S; S.init(T, NIN, G, bx);
        pg8::EpiInProj E{HB, SS1, 1.f / DM, EPS, T, (LAS float*)(lds + 131072), (const float*)(ws + WS_GT)};
        pg8::gemm_phase<pg8::EpiInProj, pg8::StaticOrder, true, true>(lds, g, S, E, wave);
    }
    GRID_BAR();

#endif
#ifndef NO_S4
    for (int rep_ = 0; rep_ < REP_S4; ++rep_)
    {   PHASE_PTRS
        att::Seam S; char* alds = (char*)lds_raw;
        const int vcu = (G % 8 == 0) ? (bx % 8) * (G / 8) + bx / 8 : bx;
        for (int v = vcu; v < 256; v += G) if (v >= 192 && v < 208) {
            pg8::Gemm g2{MN, BT_MEM, MROWS, 1024, DM}; pg8::StaticOrder S2; S2.init(MROWS, 1024, 16, v - 192);
            pg8::EpiMemKV E2{MKV, MROWS, EPS, (LAS float*)(lds + 131072), p.in[I_MKG]};
            pg8::gemm_phase<pg8::EpiMemKV, pg8::StaticOrder, true, true>(lds, g2, S2, E2, wave);
            asm volatile("s_waitcnt vmcnt(0)" ::: "memory"); __syncthreads();
            if (wave == 0 && mk_lane() == 0) { __builtin_amdgcn_fence(__ATOMIC_RELEASE, "agent"); asm volatile("s_waitcnt vmcnt(0)" ::: "memory"); (void)xb_add(&BAR[MEMFLAG], 1u); }
        }
        for (int v = vcu; v < 256; v += G) {
            const int u_ = v - 192, ns_ = u_ < 16 ? 4 : (u_ < 48 ? 7 : 6), n = v < 192 ? 2 : (u_ < 16 ? 8 : (u_ < 48 ? 8 : 10));
#define S4_MEMWAIT() do { if (wave == 0 && mk_lane() == 0) { XB_SPIN(xb_ld(&BAR[MEMFLAG]) < 16u, BAR); __builtin_amdgcn_fence(__ATOMIC_ACQUIRE, "agent"); asm volatile("s_waitcnt vmcnt(0)" ::: "memory"); } __syncthreads(); } while (0)
            { att::BlockRef c0; get_block(v, 0, c0, HB, MKV, MIX, LOGF, p.in[I_SINK]); att::attn_prime(c0, alds, S, wave); }
            for (int i = 0; i < n; ++i) {
                if (v >= 192 && i == ns_ - 1) S4_MEMWAIT();
                att::BlockRef cur, nxt; get_block(v, i, cur, HB, MKV, MIX, LOGF, p.in[I_SINK]);
                get_block(v, (i + 1 < n) ? i + 1 : i, nxt, HB, MKV, MIX, LOGF, p.in[I_SINK]);
                att::attn_block(cur, nxt, alds, S, wave);
            }
            if (v < 96) {
                S4_MEMWAIT();
                att::BlockRef c2; get_block(v, 2, c2, HB, MKV, MIX, LOGF, p.in[I_SINK]); att::attn_prime(c2, alds, S, wave);
                att::attn_block(c2, c2, alds, S, wave);
            }
#undef S4_MEMWAIT
        }
    }
#endif
    GRID_BAR();

#ifndef ONLY_S4
    for (int rep_ = 0; rep_ < REP_SYNC; ++rep_) GRID_BAR();
    {   PHASE_PTRS
        pg8::Gemm g{MIX, BT_OUT, T, DM, DM}; pg8::StaticOrder S; S.init(T, DM, G, bx);
        pg8::EpiResid<true, true, true, false> E{nullptr, X1B, nullptr, X2B, SS2};
        pg8::gemm_phase<pg8::EpiResid<true, true, true, false>, pg8::StaticOrder, true, true>(lds, g, S, E, wave);
    }
    GRID_BAR();

    {   PHASE_PTRS
        pg8::Gemm g{X2B, BT_UP2, T, NUP, DM}; pg8::StaticOrder S; S.init(T, NUP, G, bx);
        pg8::EpiSwiglu E{ACT, DFF, SS2, 1.f / DM, EPS};
        pg8::gemm_phase<pg8::EpiSwiglu, pg8::StaticOrder, true, true>(lds, g, S, E, wave);
    }
    GRID_BAR();

    {   PHASE_PTRS
        pg8::Gemm g{ACT, BT_DN2, T, DM, DFF}; pg8::StaticOrder S; S.init(T, DM, G, bx);
        pg8::EpiResid<false, true, false, true> E{nullptr, X2B, out, nullptr, nullptr};
        pg8::gemm_phase<pg8::EpiResid<false, true, false, true>, pg8::StaticOrder, true, true>(lds, g, S, E, wave);
    }
#endif
}

extern "C" void kernel_launch(void* const* d_in, const int* in_sizes, int n_in, void* d_out, int out_size, void* d_ws, size_t ws_size, hipStream_t stream) {
    static int grid = 0;
    if (grid == 0) {
        if (n_in != 24 || in_sizes[0] != T * DM || out_size != T * DM || ws_size < WS_END) { fprintf(stderr, "kernel_launch: shape/workspace mismatch (n_in %d, in0 %d, out %d, ws %zu)\n", n_in, n_in > 0 ? in_sizes[0] : -1, out_size, ws_size); grid = -1; return; }
        int dev = 0, cus = 0, per_cu = 0;
        (void)hipGetDevice(&dev); (void)hipDeviceGetAttribute(&cus, hipDeviceAttributeMultiprocessorCount, dev);
        if (hipFuncSetAttribute((const void*)fwd_megakernel, hipFuncAttributeMaxDynamicSharedMemorySize, LDS_BYTES) != hipSuccess) fprintf(stderr, "kernel_launch: hipFuncSetAttribute failed\n");
        if (hipOccupancyMaxActiveBlocksPerMultiprocessor(&per_cu, (const void*)fwd_megakernel, 512, LDS_BYTES) != hipSuccess || per_cu < 1) { per_cu = 1; (void)hipGetLastError(); }
        if (cus <= 0) cus = 256;
        grid = cus * per_cu; if (grid > 256) grid = 256;
    }
    if (grid < 0) return;
    if (hipMemsetAsync((char*)d_ws + WS_BAR, 0, BAR_BYTES, stream) != hipSuccess) { fprintf(stderr, "kernel_launch: hipMemsetAsync failed\n"); return; }
    Params p{};
    for (int i = 0; i < 24; ++i) p.in[i] = (const float*)d_in[i];
    p.out = (float*)d_out; p.ws = (unsigned char*)d_ws;
    void* args[] = {&p};
    hipError_t e = hipLaunchCooperativeKernel((const void*)fwd_megakernel, dim3(grid), dim3(512), args, LDS_BYTES, stream);
    if (e != hipSuccess) fprintf(stderr, "cooperative launch failed: %s (grid %d)\n", hipGetErrorString(e), grid);
}
```
